# Optimizing an MI355X kernel written in HIP

```python
import math
import jax, jax.numpy as jnp
from jax import lax
import numpy as np

D_MODEL = 1024
BATCH = 4
SEQ = 4096
DEPTH = 2

N_MEM = 256
CHUNK = 128
A_GROUPS = 8
A_WIDTH = 1024
A_GROUP_DIM = A_WIDTH // A_GROUPS
B_HEADS = 10
B_WIDTH = 1280
B_HEAD_DIM = B_WIDTH // B_HEADS
CONV_WIDTH = 4
LRU_C = 8.0
C_HEADS = 4
C_HEAD_DIM = 256
C_WIDTH = C_HEADS * C_HEAD_DIM
N_BRANCH = 3
IN_WIDTH = 2 * A_WIDTH + 2 * B_WIDTH + C_WIDTH + N_BRANCH * D_MODEL
SPLIT_POINTS = (A_WIDTH, 2 * A_WIDTH, 2 * A_WIDTH + B_WIDTH, 2 * A_WIDTH + 2 * B_WIDTH,
                2 * A_WIDTH + 2 * B_WIDTH + C_WIDTH)
N_GROUPS = 4
EXPERTS_PER_GROUP = 4
N_EXPERTS = N_GROUPS * EXPERTS_PER_GROUP
TOP_K = 2
D_EXPERT = 256
ALPHA = (2 * DEPTH) ** 0.25
BETA = (8 * DEPTH) ** -0.25
LN_EPS = 1e-5

kernel_name = "hybrid_gmlp_rglru_memattn_hmoe_deepnorm"


def layer_norm(x, g, b):
    xf = x.astype(jnp.float32)
    mu = jnp.mean(xf, axis=-1, keepdims=True)
    var = jnp.mean(jnp.square(xf - mu), axis=-1, keepdims=True)
    y = (xf - mu) * lax.rsqrt(var + LN_EPS)
    return (y * g.astype(jnp.float32) + b.astype(jnp.float32)).astype(x.dtype)


def spatial_gating(u, v, ln_g, ln_b, w_s, b_s):
    bsz, seq, _ = v.shape
    n_chunks = seq // CHUNK
    v = layer_norm(v, ln_g, ln_b)
    causal = jnp.tril(jnp.ones((CHUNK, CHUNK), dtype=bool))
    w = jnp.where(causal[None], w_s, jnp.zeros_like(w_s))
    vc = v.reshape(bsz, n_chunks, CHUNK, A_GROUPS, A_GROUP_DIM)
    s = jnp.einsum('gts,bcsgd->bctgd', w, vc) + b_s.T[None, None, :, :, None]
    return u * s.reshape(bsz, seq, A_WIDTH)


def causal_depthwise_conv(x, w, b):
    seq = x.shape[1]
    xp = jnp.pad(x, ((0, 0), (CONV_WIDTH - 1, 0), (0, 0)))
    out = b
    for k in range(CONV_WIDTH):
        out = out + w[k] * xp[:, k:k + seq]
    return out


def rg_lru(x, w_a, b_a, w_x, b_x, lam):
    bsz, seq, _ = x.shape
    xh = x.reshape(bsz, seq, B_HEADS, B_HEAD_DIM)
    r = jax.nn.sigmoid(jnp.einsum('bshi,hij->bshj', xh, w_a).reshape(bsz, seq, B_WIDTH) + b_a)
    i = jax.nn.sigmoid(jnp.einsum('bshi,hij->bshj', xh, w_x).reshape(bsz, seq, B_WIDTH) + b_x)
    log_a = -LRU_C * r.astype(jnp.float32) * jax.nn.softplus(-lam.astype(jnp.float32))
    a = jnp.exp(log_a)
    mult = jnp.sqrt(-jnp.expm1(2.0 * log_a))
    bx = mult * (i * x).astype(jnp.float32)

    def combine(c1, c2):
        a1, b1 = c1
        a2, b2 = c2
        return a1 * a2, a2 * b1 + b2

    _, h = lax.associative_scan(combine, (a, bx), axis=1)
    return h.astype(x.dtype)


def memory_attention(q, mem_n, w_kv):
    bsz, seq, _ = q.shape
    kv = jnp.einsum('bmd,de->bme', mem_n, w_kv)
    k, v = jnp.split(kv, 2, axis=-1)
    qh = q.reshape(bsz, seq, C_HEADS, C_HEAD_DIM)
    kh = k.reshape(bsz, N_MEM, C_HEADS, C_HEAD_DIM)
    vh = v.reshape(bsz, N_MEM, C_HEADS, C_HEAD_DIM)
    scores = jnp.einsum('bshd,bmhd->bhsm', qh, kh).astype(jnp.float32) * (C_HEAD_DIM ** -0.5)
    p = jax.nn.softmax(scores, axis=-1).astype(q.dtype)
    o = jnp.einsum('bhsm,bmhd->bshd', p, vh)
    return o.reshape(bsz, seq, C_WIDTH)


def hybrid_mixer(x, mem_n, w_in, b_in, ln_v_g, ln_v_b, w_s, b_s, conv_w, conv_b,
                 w_a, b_a, w_x, b_x, lam, w_kv, p_a, p_b, p_c, w_o, b_o):
    z = jnp.einsum('bsd,de->bse', x, w_in) + b_in
    u_a, v_a, x_b, gate_b, q_c, merge = jnp.split(z, SPLIT_POINTS, axis=-1)
    o_a = spatial_gating(jax.nn.gelu(u_a), jax.nn.gelu(v_a), ln_v_g, ln_v_b, w_s, b_s)
    o_b = rg_lru(causal_depthwise_conv(x_b, conv_w, conv_b), w_a, b_a, w_x, b_x, lam) * jax.nn.gelu(gate_b)
    o_c = memory_attention(q_c, mem_n, w_kv)
    g_a, g_b, g_c = jnp.split(jax.nn.sigmoid(merge), N_BRANCH, axis=-1)
    y = (g_a * jnp.einsum('bse,ed->bsd', o_a, p_a)
         + g_b * jnp.einsum('bse,ed->bsd', o_b, p_b)
         + g_c * jnp.einsum('bse,ed->bsd', o_c, p_c))
    return jnp.einsum('bsd,de->bse', y, w_o) + b_o


def hierarchical_moe(x, w_rg, b_rg, w_re, b_re, w_up, w_down):
    bsz, seq, d = x.shape
    xf = x.reshape(bsz * seq, d)
    n_tok = xf.shape[0]
    group_p = jax.nn.softmax((xf @ w_rg + b_rg).astype(jnp.float32), axis=-1)
    p_top, g_top = lax.top_k(group_p, 1)
    exp_logits = (xf @ w_re + b_re).astype(jnp.float32).reshape(n_tok, N_GROUPS, EXPERTS_PER_GROUP)
    in_group = exp_logits[jnp.arange(n_tok), g_top[:, 0]]
    e_p, e_idx = lax.top_k(jax.nn.softmax(in_group, axis=-1), TOP_K)
    weights = p_top * e_p / jnp.sum(e_p, axis=-1, keepdims=True)
    expert_id = g_top * EXPERTS_PER_GROUP + e_idx
    gate = jnp.sum(jax.nn.one_hot(expert_id, N_EXPERTS, dtype=jnp.float32) * weights[..., None],
                   axis=1).astype(x.dtype)
    h = jnp.einsum('nd,edf->nef', xf, w_up)
    h_g, h_u = jnp.split(h, 2, axis=-1)
    h = jax.nn.silu(h_g) * h_u * gate[:, :, None]
    y = jnp.einsum('nef,efd->nd', h, w_down)
    return y.reshape(bsz, seq, d)


def setup_inputs(seed: int = 0) -> dict:
    key = jax.random.key(seed)
    ks = jax.random.split(key, 40)
    f32 = jnp.float32

    def nrm(k, shape, scale):
        return jax.random.normal(k, shape, dtype=f32) * scale

    lam_u = jax.random.uniform(ks[18], (DEPTH, B_WIDTH), dtype=f32, minval=0.9, maxval=0.999)
    a0 = lam_u ** (1.0 / LRU_C)
    lam = jnp.log(a0) - jnp.log1p(-a0)
    return {
        "x": nrm(ks[0], (BATCH, SEQ, D_MODEL), 1.0),
        "mem": nrm(ks[1], (BATCH, N_MEM, D_MODEL), 1.0),
        "ln_in_g": 1.0 + nrm(ks[2], (D_MODEL,), 0.02),
        "ln_in_b": nrm(ks[3], (D_MODEL,), 0.02),
        "ln_mem_g": 1.0 + nrm(ks[4], (D_MODEL,), 0.02),
        "ln_mem_b": nrm(ks[5], (D_MODEL,), 0.02),
        "w_in": nrm(ks[6], (DEPTH, D_MODEL, IN_WIDTH), D_MODEL ** -0.5),
        "b_in": nrm(ks[7], (DEPTH, IN_WIDTH), 0.02),
        "ln_v_g": 1.0 + nrm(ks[8], (DEPTH, A_WIDTH), 0.02),
        "ln_v_b": nrm(ks[9], (DEPTH, A_WIDTH), 0.02),
        "w_s": nrm(ks[10], (DEPTH, A_GROUPS, CHUNK, CHUNK), CHUNK ** -0.5),
        "b_s": 1.0 + nrm(ks[11], (DEPTH, A_GROUPS, CHUNK), 0.02),
        "conv_w": nrm(ks[12], (DEPTH, CONV_WIDTH, B_WIDTH), CONV_WIDTH ** -0.5),
        "conv_b": nrm(ks[13], (DEPTH, B_WIDTH), 0.02),
        "w_a": nrm(ks[14], (DEPTH, B_HEADS, B_HEAD_DIM, B_HEAD_DIM), B_HEAD_DIM ** -0.5),
        "b_a": nrm(ks[15], (DEPTH, B_WIDTH), 0.02),
        "w_x": nrm(ks[16], (DEPTH, B_HEADS, B_HEAD_DIM, B_HEAD_DIM), B_HEAD_DIM ** -0.5),
        "b_x": nrm(ks[17], (DEPTH, B_WIDTH), 0.02),
        "lam": lam,
        "w_kv": nrm(ks[19], (DEPTH, D_MODEL, 2 * C_WIDTH), D_MODEL ** -0.5),
        "p_a": nrm(ks[20], (DEPTH, A_WIDTH, D_MODEL), A_WIDTH ** -0.5),
        "p_b": nrm(ks[21], (DEPTH, B_WIDTH, D_MODEL), B_WIDTH ** -0.5),
        "p_c": nrm(ks[22], (DEPTH, C_WIDTH, D_MODEL), C_WIDTH ** -0.5),
        "w_o": nrm(ks[23], (DEPTH, D_MODEL, D_MODEL), BETA * D_MODEL ** -0.5),
        "b_o": nrm(ks[24], (DEPTH, D_MODEL), 0.02),
        "ln1_g": 1.0 + nrm(ks[25], (DEPTH, D_MODEL), 0.02),
        "ln1_b": nrm(ks[26], (DEPTH, D_MODEL), 0.02),
        "w_rg": nrm(ks[27], (DEPTH, D_MODEL, N_GROUPS), D_MODEL ** -0.5),
        "b_rg": nrm(ks[28], (DEPTH, N_GROUPS), 0.01),
        "w_re": nrm(ks[29], (DEPTH, D_MODEL, N_EXPERTS), D_MODEL ** -0.5),
        "b_re": nrm(ks[30], (DEPTH, N_EXPERTS), 0.01),
        "w_up": nrm(ks[31], (DEPTH, N_EXPERTS, D_MODEL, 2 * D_EXPERT), D_MODEL ** -0.5),
        "w_down": nrm(ks[32], (DEPTH, N_EXPERTS, D_EXPERT, D_MODEL), BETA * D_EXPERT ** -0.5),
        "ln2_g": 1.0 + nrm(ks[33], (DEPTH, D_MODEL), 0.02),
        "ln2_b": nrm(ks[34], (DEPTH, D_MODEL), 0.02),
    }


def reference(x, mem, ln_in_g, ln_in_b, ln_mem_g, ln_mem_b, w_in, b_in, ln_v_g, ln_v_b,
              w_s, b_s, conv_w, conv_b, w_a, b_a, w_x, b_x, lam, w_kv, p_a, p_b, p_c,
              w_o, b_o, ln1_g, ln1_b, w_rg, b_rg, w_re, b_re, w_up, w_down, ln2_g, ln2_b):
    x = layer_norm(x, ln_in_g, ln_in_b)
    mem_n = layer_norm(mem, ln_mem_g, ln_mem_b)
    for l in range(DEPTH):
        m = hybrid_mixer(x, mem_n, w_in[l], b_in[l], ln_v_g[l], ln_v_b[l], w_s[l], b_s[l],
                         conv_w[l], conv_b[l], w_a[l], b_a[l], w_x[l], b_x[l], lam[l],
                         w_kv[l], p_a[l], p_b[l], p_c[l], w_o[l], b_o[l])
        x = layer_norm(ALPHA * x + m, ln1_g[l], ln1_b[l])
        f = hierarchical_moe(x, w_rg[l], b_rg[l], w_re[l], b_re[l], w_up[l], w_down[l])
        x = layer_norm(ALPHA * x + f, ln2_g[l], ln2_b[l])
    return x
```

```cpp
#include <hip/hip_runtime.h>
#include <cstdio>
#include <cstdint>

#ifndef DBG_FSCALE
#define DBG_FSCALE 1.0f
#endif
#ifndef DBG_ZA
#define DBG_ZA 0
#endif
#ifndef DBG_ZB
#define DBG_ZB 0
#endif
#ifndef DBG_ZC
#define DBG_ZC 0
#endif
#ifndef USE_FUSED_LN
#define USE_FUSED_LN 0
#endif
#ifndef DBG_LAYER
#define DBG_LAYER 0
#define DBG_W0 0
#define DBG_W1 0
#define DBG_W2 0
#define DBG_CNT 0
#endif
#ifndef MK_PER_PHASE
#define MK_PER_PHASE 1
#endif

namespace pg8 {
#define PG8_LAS __attribute__((address_space(3)))
typedef unsigned short bf16_t;
typedef short bf16x8 __attribute__((ext_vector_type(8)));
typedef float f32x4 __attribute__((ext_vector_type(4)));
typedef float f32x2 __attribute__((ext_vector_type(2)));
typedef unsigned u32x4 __attribute__((ext_vector_type(4)));
typedef unsigned u32x2 __attribute__((ext_vector_type(2)));
constexpr int BM = 256, BK = 64, HALF = 128, HTB = HALF * BK * 2, STAGE_BYTES = 8 * HTB, NXCD = 8, WGM = 8;

__host__ __device__ __forceinline__ int lds_byte(int r, int c) { const int st = (r >> 4) * 2 + (c >> 5), rr = r & 15, cc = c & 31, ob = rr * 64 + cc * 2; return st * 1024 + (ob ^ (((ob >> 9) & 1) << 5)); }
__host__ __device__ __forceinline__ void stage_rc(int b, int& R, int& C) { const int st = b / 1024, sb = b % 1024, swz = sb ^ (((sb >> 9) & 1) << 5); R = (st >> 1) * 16 + swz / 64; C = (st & 1) * 32 + (swz % 64) / 2; }
__host__ __device__ __forceinline__ int perm32(int rho) { const int n = rho >> 4, i = rho & 15; return 8 * (i >> 2) + 4 * n + (i & 3); }

struct Unit { const char* A; const char* B; int K; int pm, pn, seg; };

typedef __bf16 bf16x2_t __attribute__((ext_vector_type(2)));
__device__ __forceinline__ unsigned cvt_pk_bf16(float lo, float hi) { f32x2 v = {lo, hi}; bf16x2_t b = __builtin_convertvector(v, bf16x2_t); return __builtin_bit_cast(unsigned, b); }
__device__ __forceinline__ float bf_lo(unsigned w) { return __uint_as_float(w << 16); }
__device__ __forceinline__ float bf_hi(unsigned w) { return __uint_as_float(w & 0xffff0000u); }
__device__ __forceinline__ float fast_sigmoid(float x) { return __builtin_amdgcn_rcpf(1.0f + __builtin_amdgcn_exp2f(-1.4426950408889634f * x)); }
__device__ __forceinline__ float gelu_tanh(float x) { const float u = x * (1.0f + 0.044715f * x * x); return x * __builtin_amdgcn_rcpf(1.0f + __builtin_amdgcn_exp2f(-2.302208198f * u)); }

template <int ACT  >
__device__ __forceinline__ void store_tile_bf16(const f32x4 (&acc)[2][2][4][2], bf16_t* tile, int ldc, const float* bias, float sc, int wr, int wc, int fr, int fq) {
    const int c0 = wc * 32 + 8 * fq;
    f32x4 bv[2][2];
#pragma unroll
    for (int bj = 0; bj < 2; ++bj)
#pragma unroll
        for (int n = 0; n < 2; ++n) bv[bj][n] = bias ? *(const f32x4*)(bias + c0 + bj * HALF + 4 * n) : (f32x4){0.f, 0.f, 0.f, 0.f};
#pragma unroll
    for (int ai = 0; ai < 2; ++ai)
#pragma unroll
        for (int m = 0; m < 4; ++m) { bf16_t* rowp = tile + (unsigned)((ai * HALF + wr * 64 + m * 16 + fr) * ldc + c0);
#pragma unroll
            for (int bj = 0; bj < 2; ++bj) { f32x4 v0 = acc[ai][bj][m][0] + bv[bj][0], v1 = acc[ai][bj][m][1] + bv[bj][1];
                if (ACT == 1) { for (int e = 0; e < 4; ++e) { v0[e] = gelu_tanh(v0[e]); v1[e] = gelu_tanh(v1[e]); } }
                if (ACT == 2) { for (int e = 0; e < 4; ++e) { v0[e] = fast_sigmoid(v0[e]); v1[e] = fast_sigmoid(v1[e]); } }
                v0 = v0 * sc; v1 = v1 * sc; u32x4 w; w.x = cvt_pk_bf16(v0[0], v0[1]); w.y = cvt_pk_bf16(v0[2], v0[3]); w.z = cvt_pk_bf16(v1[0], v1[1]); w.w = cvt_pk_bf16(v1[2], v1[3]);
                *(u32x4*)(rowp + bj * HALF) = w; } }
}

struct PanelStats {
    unsigned* xbuf;
    unsigned* cnt;
    unsigned* tmo;
    int ntn; float eps; unsigned code;
    __device__ __forceinline__ bool run(const f32x4 (&v)[2][2][4][2], const Unit& u, int wr, int wc, int fr, int fq, PG8_LAS unsigned char* lds, int wid, int lane) const {
        typedef float f32x2v __attribute__((ext_vector_type(2)));
        PG8_LAS f32x2v* P = (PG8_LAS f32x2v*)lds;
        PG8_LAS f32x2v* S = (PG8_LAS f32x2v*)(lds + 8192);
        PG8_LAS unsigned* flag = (PG8_LAS unsigned*)(lds + 8192 + 2048);
#pragma unroll
        for (int ai = 0; ai < 2; ++ai)
#pragma unroll
            for (int m = 0; m < 4; ++m) {
                float s = 0.f;
#pragma unroll
                for (int bj = 0; bj < 2; ++bj)
#pragma unroll
                    for (int n = 0; n < 2; ++n) { const f32x4 x = v[ai][bj][m][n]; s += (x[0] + x[1]) + (x[2] + x[3]); }
                s += __shfl_xor(s, 16); s += __shfl_xor(s, 32);
                const float mw = s * (1.0f / 64.0f); float q = 0.f;
#pragma unroll
                for (int bj = 0; bj < 2; ++bj)
#pragma unroll
                    for (int n = 0; n < 2; ++n) { const f32x4 d = v[ai][bj][m][n] - mw; q += (d[0] * d[0] + d[1] * d[1]) + (d[2] * d[2] + d[3] * d[3]); }
                q += __shfl_xor(q, 16); q += __shfl_xor(q, 32);
                if (fq == 0) P[(ai * HALF + wr * 64 + m * 16 + fr) * 4 + wc] = (f32x2v){mw, q};
            }
        asm volatile("s_waitcnt lgkmcnt(0)" ::: "memory"); __builtin_amdgcn_s_barrier(); asm volatile("" ::: "memory");
        const int row = wid * 32 + (lane & 31);
        if (lane < 32) {
            const f32x2v a = P[row * 4 + 0], b = P[row * 4 + 1], c = P[row * 4 + 2], d = P[row * 4 + 3];
            const float mt = (a.x + b.x + c.x + d.x) * 0.25f;
            const float da = a.x - mt, db = b.x - mt, dc = c.x - mt, dd = d.x - mt;
            const float m2 = (a.y + b.y) + (c.y + d.y) + 64.0f * ((da * da + db * db) + (dc * dc + dd * dd));
            unsigned long long* slot = (unsigned long long*)xbuf + ((size_t)(u.pm * BM + row) * 4 + u.pn);
            __hip_atomic_store(slot, ((unsigned long long)__float_as_uint(m2) << 32) | __float_as_uint(mt), __ATOMIC_RELAXED, __HIP_MEMORY_SCOPE_AGENT);
        }
        asm volatile("s_waitcnt vmcnt(0)" ::: "memory");
        if (lane == 0) __hip_atomic_fetch_add(cnt + 64 * u.pm, 1u, __ATOMIC_RELAXED, __HIP_MEMORY_SCOPE_AGENT);
        if (wid == 0) {
            bool dead = false; const unsigned long long t0 = __builtin_amdgcn_s_memrealtime(); const unsigned want = 8u * (unsigned)ntn;
            for (;;) {
                if ((unsigned)__builtin_amdgcn_readfirstlane(__hip_atomic_load(cnt + 64 * u.pm, __ATOMIC_RELAXED, __HIP_MEMORY_SCOPE_AGENT)) >= want) break;
                if (__builtin_amdgcn_s_memrealtime() - t0 > 2000000ull) {
                    if (lane == 0) { unsigned expect = 0u; __hip_atomic_compare_exchange_strong(tmo + 1, &expect, code | (unsigned)(u.pm & 0xff), __ATOMIC_RELAXED, __ATOMIC_RELAXED, __HIP_MEMORY_SCOPE_AGENT);
                                     __hip_atomic_store(tmo, 1u, __ATOMIC_RELAXED, __HIP_MEMORY_SCOPE_AGENT); }
                    dead = true; break; }
                __builtin_amdgcn_s_sleep(2);
            }
            __builtin_amdgcn_fence(__ATOMIC_ACQUIRE, "agent");
            if (lane == 0) flag[0] = dead ? 1u : 0u;
        }
        asm volatile("s_waitcnt vmcnt(0) lgkmcnt(0)" ::: "memory"); __builtin_amdgcn_s_barrier(); asm volatile("" ::: "memory");
        const bool bad = flag[0] != 0u;
        if (lane < 32) {
            const unsigned long long* slot = (const unsigned long long*)xbuf + (size_t)(u.pm * BM + row) * 4; float mt[4], m2[4]; float ms = 0.f;
#pragma unroll
            for (int t = 0; t < 4; ++t) { if (t < ntn) { const unsigned long long w = __hip_atomic_load(slot + t, __ATOMIC_RELAXED, __HIP_MEMORY_SCOPE_AGENT); mt[t] = __uint_as_float((unsigned)w); m2[t] = __uint_as_float((unsigned)(w >> 32)); } else { mt[t] = 0.f; m2[t] = 0.f; } ms += mt[t]; }
            const float mean = ms / (float)ntn; float q = 0.f;
#pragma unroll
            for (int t = 0; t < 4; ++t) if (t < ntn) { const float dm = mt[t] - mean; q += m2[t] + 256.0f * dm * dm; }
            S[row] = (f32x2v){mean, 1.0f / sqrtf(q / (256.0f * (float)ntn) + eps)};
        }
        asm volatile("s_waitcnt lgkmcnt(0)" ::: "memory"); __builtin_amdgcn_s_barrier(); asm volatile("" ::: "memory");
        return bad;
    }
};

template <class Epi, class Sched, bool ALIGN_EPI>
__device__ __forceinline__ void gemm_phase(PG8_LAS unsigned char* lds, const Sched& S, const Epi& E) {
    int tid_ = threadIdx.x; asm volatile("" : "+v"(tid_));
    const int tid = tid_, wid = __builtin_amdgcn_readfirstlane(tid >> 6), lane = tid & 63, wr = wid >> 2, wc = wid & 3, fr = lane & 15, fq = lane >> 4;
    const size_t kstep = (size_t)(BK * 2);
    const unsigned ldsw = (unsigned)wid * 1024u;
    const int aoff = lds_byte(wr * 64 + fr, fq * 8), boff = lds_byte(wc * 32 + fr, fq * 8);
#define PG8_VOFF(K_, vA_, vB_) do { _Pragma("unroll") for (int _i = 0; _i < 2; ++_i) { int R_, C_; stage_rc(tid * 16 + _i * 8192, R_, C_); const int Rb_ = Epi::PERM ? ((R_ & ~31) + perm32(R_ & 31)) : R_; \
        vA_[_i] = (unsigned)(R_ * (K_) + C_) * 2u; vB_[_i] = (unsigned)(Rb_ * (K_) + C_) * 2u; } } while (0)
#define PG8_SA(b, h) (((b) * 2 + (h)) * HTB)
#define PG8_SB(b, h) ((4 + (b) * 2 + (h)) * HTB)
#define PG8_STAGE(bufoff, gbase, voff) do { _Pragma("unroll") for (int _i = 0; _i < 2; ++_i) \
        __builtin_amdgcn_global_load_lds((const unsigned*)((const char*)(gbase) + (voff)[_i]), (PG8_LAS unsigned*)(lds + (bufoff) + ldsw + _i * 8192), 16, 0, 0); } while (0)
#define PG8_LDA(dst, b, h) do { _Pragma("unroll") for (int m = 0; m < 4; ++m) _Pragma("unroll") for (int k = 0; k < 2; ++k) dst[m][k] = *(const PG8_LAS bf16x8*)(lds + PG8_SA(b, h) + aoff + m * 2048 + k * 1024); } while (0)
#define PG8_LDB(dst, b, h) do { _Pragma("unroll") for (int n = 0; n < 2; ++n) _Pragma("unroll") for (int k = 0; k < 2; ++k) dst[n][k] = *(const PG8_LAS bf16x8*)(lds + PG8_SB(b, h) + boff + n * 2048 + k * 1024); } while (0)
#define PG8_MMA(ai, bj, At, Bt) do { __builtin_amdgcn_s_setprio(1); _Pragma("unroll") for (int m = 0; m < 4; ++m) _Pragma("unroll") for (int n = 0; n < 2; ++n) _Pragma("unroll") for (int k = 0; k < 2; ++k) \
        acc[ai][bj][m][n] = __builtin_amdgcn_mfma_f32_16x16x32_bf16(Bt[n][k], At[m][k], acc[ai][bj][m][n], 0, 0, 0); __builtin_amdgcn_s_setprio(0); } while (0)
#define PG8_WAIT_V(n) asm volatile("s_waitcnt vmcnt(" #n ")" ::: "memory")
#define PG8_WAIT_L(n) asm volatile("s_waitcnt lgkmcnt(" #n ")" ::: "memory")
#define PG8_BAR __builtin_amdgcn_s_barrier()
#define PG8_SCHED __builtin_amdgcn_sched_barrier(0)
    Unit cur, nxt; int ui = 0;
    if (!S.next(0, cur)) return;
    f32x4 acc[2][2][4][2];
#pragma unroll
    for (int a = 0; a < 2; ++a)
#pragma unroll
        for (int b = 0; b < 2; ++b)
#pragma unroll
            for (int m = 0; m < 4; ++m)
#pragma unroll
                for (int n = 0; n < 2; ++n) acc[a][b][m][n] = (f32x4){0.f, 0.f, 0.f, 0.f};
    bf16x8 At[4][2], B0[2][2], B1[2][2];
    unsigned vAc[2], vBc[2]; PG8_VOFF(S.ld, vAc, vBc);
    const char* cA = cur.A; const char* cB = cur.B; const size_t hsC = (size_t)HALF * S.ld * 2;
    S.a_ready(cur);
    PG8_STAGE(PG8_SB(0, 0), cB, vBc); PG8_STAGE(PG8_SB(0, 1), cB + hsC, vBc); PG8_STAGE(PG8_SA(0, 0), cA, vAc); PG8_STAGE(PG8_SA(0, 1), cA + hsC, vAc);
    if (wr == 1) PG8_BAR;
    PG8_WAIT_V(2); PG8_BAR;
    PG8_STAGE(PG8_SB(1, 0), cB + kstep, vBc); PG8_STAGE(PG8_SA(1, 0), cA + kstep, vAc); PG8_STAGE(PG8_SB(1, 1), cB + hsC + kstep, vBc);
    PG8_WAIT_V(6); PG8_BAR;
    for (;;) {
        const bool has_next = S.next(ui + 1, nxt);
        if (!has_next) nxt = cur;
        const char* nA = nxt.A; const char* nB = nxt.B;
        const int nt = cur.K / BK;
        for (int t = 0; t < nt; t += 2) {
            const bool last = (t == nt - 2);
            const char* a1 = cA + (size_t)(t + 1) * kstep;
            const char* a2 = last ? nA : cA + (size_t)(t + 2) * kstep; const char* b2 = last ? nB : cB + (size_t)(t + 2) * kstep;
            const char* a3 = a2 + kstep; const char* b3 = b2 + kstep;
            if (last && has_next) S.a_ready(nxt);
            PG8_LDB(B0, 0, 0); PG8_LDB(B1, 0, 1); PG8_SCHED; PG8_LDA(At, 0, 0); PG8_STAGE(PG8_SA(1, 1), a1 + hsC, vAc);
            PG8_WAIT_V(8); PG8_WAIT_L(0); PG8_BAR; PG8_MMA(0, 0, At, B0); PG8_MMA(0, 1, At, B1); PG8_BAR; PG8_SCHED;
            PG8_LDA(At, 0, 1); PG8_STAGE(PG8_SB(0, 0), b2, vBc); PG8_STAGE(PG8_SB(0, 1), b2 + hsC, vBc); PG8_STAGE(PG8_SA(0, 0), a2, vAc);
            PG8_WAIT_V(8); PG8_WAIT_L(0); PG8_BAR; PG8_MMA(1, 0, At, B0); PG8_MMA(1, 1, At, B1); PG8_BAR; PG8_SCHED;
            PG8_LDB(B0, 1, 0); PG8_LDB(B1, 1, 1); PG8_SCHED; PG8_LDA(At, 1, 0); PG8_STAGE(PG8_SA(0, 1), a2 + hsC, vAc);
            PG8_WAIT_V(8); PG8_WAIT_L(0); PG8_BAR; PG8_MMA(0, 0, At, B0); PG8_MMA(0, 1, At, B1); PG8_BAR; PG8_SCHED;
            PG8_LDA(At, 1, 1); PG8_STAGE(PG8_SB(1, 0), b3, vBc); PG8_STAGE(PG8_SB(1, 1), b3 + hsC, vBc); PG8_STAGE(PG8_SA(1, 0), a3, vAc);
            PG8_WAIT_V(8); PG8_WAIT_L(0); PG8_BAR; PG8_MMA(1, 0, At, B0); PG8_MMA(1, 1, At, B1); PG8_BAR; PG8_SCHED;
        }
        if constexpr (ALIGN_EPI) { if (wr == 0) PG8_BAR; }
        if constexpr (!Epi::AFTER_DRAIN) { int fr_ = fr, fq_ = fq; asm volatile("" : "+v"(fr_), "+v"(fq_));
            (void)E(acc, cur, wr, wc, fr_, fq_); S.done(cur); }
        if (!has_next) break;
        if constexpr (!Epi::KEEP) {
#pragma unroll
            for (int a = 0; a < 2; ++a)
#pragma unroll
                for (int b = 0; b < 2; ++b)
#pragma unroll
                    for (int m = 0; m < 4; ++m)
#pragma unroll
                        for (int n = 0; n < 2; ++n) acc[a][b][m][n] = (f32x4){0.f, 0.f, 0.f, 0.f};
        }
        cur = nxt; cA = nA; cB = nB; ++ui;
        if constexpr (ALIGN_EPI) { if (wr == 1) PG8_BAR; }
    }
    PG8_WAIT_V(0);
    if constexpr (!ALIGN_EPI) { if (wr == 0) PG8_BAR; }
    PG8_BAR;
    if constexpr (Epi::AFTER_DRAIN) { int fr_ = fr, fq_ = fq; asm volatile("" : "+v"(fr_), "+v"(fq_)); E.fused(acc, cur, wr, wc, fr_, fq_, lds, wid, lane); S.done(cur); }
#undef PG8_VOFF
#undef PG8_SA
#undef PG8_SB
#undef PG8_STAGE
#undef PG8_LDA
#undef PG8_LDB
#undef PG8_MMA
#undef PG8_WAIT_V
#undef PG8_WAIT_L
#undef PG8_BAR
#undef PG8_SCHED
}
}

constexpr int NB = 4, SEQ = 4096, D = 1024, M = NB * SEQ, NMEM = 256, DEPTH = 2;
constexpr int AW = 1024, BW = 1280, CW = 1024, INW = 8704, NZ1 = 5632  , NMG = 3072;
constexpr int NEXP = 16, DEXP = 256, NPAIR = 2 * M, MOE_ROWS = 36864  ;
constexpr float LN_EPS = 1e-5f, ALPHA = 1.4142135623730951f;

constexpr size_t MiB = 1u << 20;
constexpr size_t WS_CTL = 0, CTL_ZERO_BYTES = 1 * MiB;
constexpr size_t WS_XCHG = 1 * MiB;
constexpr size_t WS_SUMM = 2 * MiB;
constexpr size_t WS_META = WS_SUMM + 1310720;
constexpr size_t WS_SMALLW = 4 * MiB;
constexpr size_t WS_KV = 5 * MiB;
constexpr size_t WS_WINT = 13 * MiB;
constexpr size_t WS_PT = 30 * MiB;
constexpr size_t WS_WOT = WS_PT + 6815744;
constexpr size_t WS_XB = 39 * MiB;
constexpr int LDO = 3328;
constexpr size_t WS_O = 71 * MiB, WS_V = 175 * MiB, WS_XBR = 207 * MiB, WS_WMOE = 247 * MiB, WS_END = 271 * MiB;
constexpr int OC_U = 0, OC_GB = 1024, OC_Q = 2304;
constexpr size_t WS_GA = WS_V, WS_GBT = WS_V + 32 * MiB, WS_GC = WS_V + 64 * MiB;
constexpr size_t WS_Y = WS_XB, WS_X1B = WS_O, WS_XG = WS_V, WS_H = WS_XB, WS_F2 = WS_O + 32 * MiB;
constexpr size_t WS_MEMN = WS_WMOE, WS_WKVT = WS_WMOE + 2 * MiB;
constexpr size_t WS_WUPT = WS_WMOE, WS_WDNT = WS_WMOE + 16 * MiB;
static_assert(WS_WOT + 2 * MiB <= WS_XB && WS_META + 4 * 131072 + 147456 <= WS_SMALLW && WS_XG + (size_t)MOE_ROWS * 2048 <= WS_WMOE && WS_F2 + (size_t)MOE_ROWS * 2048 <= WS_V && WS_H + (size_t)MOE_ROWS * 512 <= WS_O && WS_O + (size_t)M * LDO * 2 <= WS_V, "d_ws map");
constexpr int CW_TMO = 0, CW_CODE = 1, CW_BAR = 4096, CW_SEAM = 16384, SEAM_BANK = 64 * 64, CW_MOE = 40960;
static_assert((CW_MOE + 2 * 16 * 64) * 4 <= (int)CTL_ZERO_BYTES, "ctl");

constexpr int RING_BYTES = 131072, LDSCTL_OFF = RING_BYTES, MISC_OFF = LDSCTL_OFF + 320, LDS_BYTES = 147456;
constexpr int NWAVES = 8;

#define GAS __attribute__((address_space(1)))
#define LAS __attribute__((address_space(3)))
typedef unsigned short bf16;
typedef unsigned v4u __attribute__((ext_vector_type(4)));
typedef unsigned v2u __attribute__((ext_vector_type(2)));
typedef float f32x4 __attribute__((ext_vector_type(4)));
typedef GAS unsigned gu32;
#define RLX_AGENT __ATOMIC_RELAXED, __HIP_MEMORY_SCOPE_AGENT
#define LDS_WAIT() asm volatile("s_waitcnt lgkmcnt(0)" ::: "memory")
#define VM_WAIT() asm volatile("s_waitcnt vmcnt(0)" ::: "memory")
__device__ __forceinline__ unsigned f2bf(float f) { unsigned u = __builtin_bit_cast(unsigned, f); return (u + 0x7fffu + ((u >> 16) & 1u)) >> 16; }
__device__ __forceinline__ unsigned pk2(float lo, float hi) { return f2bf(lo) | (f2bf(hi) << 16); }
__device__ __forceinline__ float bf2f(bf16 b) { return __uint_as_float((unsigned)b << 16); }
using pg8::bf_lo; using pg8::bf_hi;

#define XB_TMO      128
#define XB_XCNT(j)  (256  + 64 * (j))
#define XB_XSUB(j)  (1280 + 64 * (j))
#define XB_XGEN(j)  (2304 + 64 * (j))
#define XB_TOP      3328
#define XB_TOPGEN   3392
#define XCD_BAR_WORDS 3456
#define XB_SPIN_CAP (1u << 18)
__device__ __forceinline__ unsigned xb_ld(unsigned* p)              { return __hip_atomic_load(p, __ATOMIC_RELAXED, __HIP_MEMORY_SCOPE_AGENT); }
__device__ __forceinline__ unsigned xb_add(unsigned* p, unsigned v) { return __hip_atomic_fetch_add(p, v, __ATOMIC_RELAXED, __HIP_MEMORY_SCOPE_AGENT); }
__device__ __forceinline__ unsigned xb_xcc_id() { return (unsigned)__builtin_amdgcn_s_getreg((3 << 11) | 20) & 0xFu; }
#define XB_SPIN(cond, bar) do { unsigned _sp = 0; while (cond) { __builtin_amdgcn_s_sleep(1); \
    if ((++_sp & 255u) == 0u) { if (xb_ld(&(bar)[XB_TMO])) break; if (_sp > XB_SPIN_CAP) { atomicAdd(&(bar)[XB_TMO], 1u); break; } } } } while (0)
struct XcdBarrier { unsigned* bar; unsigned x; volatile LAS unsigned* st; };
__device__ __forceinline__ XcdBarrier xcd_barrier_post(unsigned* bar, volatile LAS unsigned* st) {
    XcdBarrier b; b.bar = bar; b.x = xb_xcc_id(); b.st = st;
    if (threadIdx.x == 0) (void)xb_add(&bar[XB_XCNT(b.x)], 1u);
    return b;
}
__device__ __forceinline__ void xcd_barrier_complete(unsigned* bar, unsigned x, unsigned& nloc, unsigned& nx) {
    const unsigned G = gridDim.x * gridDim.y * gridDim.z;
    unsigned sum, cnt, mine, sp = 0u;
    for (;;) {
        sum = 0u; cnt = 0u; mine = 0u;
#pragma unroll
        for (unsigned j = 0; j < 16; ++j) { const unsigned c = xb_ld(&bar[XB_XCNT(j)]); sum += c; cnt += (c > 0u) ? 1u : 0u; mine = (j == x) ? c : mine; }
        if (sum == G) break;
        __builtin_amdgcn_s_sleep(1);
        if ((++sp & 255u) == 0u) { if (xb_ld(&bar[XB_TMO])) break; if (sp > XB_SPIN_CAP) { atomicAdd(&bar[XB_TMO], 1u); break; } }
    }
    nloc = mine > 0u ? mine : 1u; nx = cnt > 0u ? cnt : 1u;
}
__device__ __forceinline__ void xcd_barrier(const XcdBarrier& b) {
    asm volatile("s_waitcnt vmcnt(0)" ::: "memory");
    __syncthreads();
    if (threadIdx.x == 0) {
        unsigned* bar = b.bar;
        __builtin_amdgcn_s_waitcnt(0);
        unsigned nloc = b.st[0], nx = b.st[1];
        if (nloc == 0u) { xcd_barrier_complete(bar, b.x, nloc, nx); b.st[0] = nloc; b.st[1] = nx; }
        const unsigned old = xb_add(&bar[XB_XSUB(b.x)], 1u);
        const unsigned gen = old / nloc;
        if (old + 1u == (gen + 1u) * nloc) {
            __builtin_amdgcn_fence(__ATOMIC_RELEASE, "agent");
            asm volatile("s_waitcnt vmcnt(0)" ::: "memory");
            const unsigned og = xb_add(&bar[XB_TOP], 1u);
            const unsigned tg = og / nx;
            if (og + 1u == (tg + 1u) * nx) xb_add(&bar[XB_TOPGEN], 1u);
            else XB_SPIN(xb_ld(&bar[XB_TOPGEN]) == tg, bar);
            __builtin_amdgcn_fence(__ATOMIC_ACQUIRE, "agent");
            xb_add(&bar[XB_XGEN(b.x)], 1u);
            asm volatile("s_waitcnt vmcnt(0)" ::: "memory");
        } else {
            XB_SPIN(xb_ld(&bar[XB_XGEN(b.x)]) == gen, bar);
            __builtin_amdgcn_fence(__ATOMIC_ACQUIRE, "agent");
            asm volatile("s_waitcnt vmcnt(0)" ::: "memory");
        }
    }
    __syncthreads();
}

struct Args { const float* in[35]; float* out; unsigned char* ws; int ph_lo, ph_hi; };
enum InIdx { I_X = 0, I_MEM, I_LN_IN_G, I_LN_IN_B, I_LN_MEM_G, I_LN_MEM_B, I_W_IN, I_B_IN, I_LN_V_G, I_LN_V_B, I_W_S, I_B_S, I_CONV_W, I_CONV_B, I_W_A, I_B_A, I_W_X, I_B_X, I_LAM,
             I_W_KV, I_P_A, I_P_B, I_P_C, I_W_O, I_B_O, I_LN1_G, I_LN1_B, I_W_RG, I_B_RG, I_W_RE, I_B_RE, I_W_UP, I_W_DOWN, I_LN2_G, I_LN2_B };
struct Frame {
    LAS unsigned char* lds; gu32* ctl; unsigned char* ws;
    int tid, lane, wave, G, bid;
};

__device__ __forceinline__ float wave_sum(float v) {
#pragma unroll
    for (int o = 1; o < 64; o <<= 1) v += __shfl_xor(v, o);
    return v;
}
__device__ __forceinline__ float wave_max(float v) {
#pragma unroll
    for (int o = 1; o < 64; o <<= 1) v = fmaxf(v, __shfl_xor(v, o));
    return v;
}

__device__ __forceinline__ void tr_item(const float* W, int K, int N, bf16* WT, int ldo, int mode, LAS float* scr, int item, int lane) {
    const int nblk = N / 32, kb = item / nblk, nb = item % nblk, k0 = 64 * kb, n0 = 32 * nb;
    int r0 = n0;
    if (mode == 1) { const int nn = n0 & 255; r0 = (nn >> 7) * 256 + (n0 >> 8) * 128 + (nn & 127); }
#pragma unroll 8
    for (int i = 0; i < 32; ++i) { const int kk = 2 * i + (lane >> 5); scr[kk * 33 + (lane & 31)] = W[(size_t)(k0 + kk) * N + n0 + (lane & 31)]; }
    LDS_WAIT(); asm volatile("" ::: "memory");
    const int c = lane & 7;
#pragma unroll
    for (int j = 0; j < 4; ++j) { const int n = (lane >> 3) + 8 * j; const LAS float* s = scr + (8 * c) * 33 + n;
        v4u o; o.x = pk2(s[0 * 33], s[1 * 33]); o.y = pk2(s[2 * 33], s[3 * 33]); o.z = pk2(s[4 * 33], s[5 * 33]); o.w = pk2(s[6 * 33], s[7 * 33]);
        *(GAS v4u*)(WT + (size_t)(r0 + n) * ldo + k0 + 8 * c) = o; }
    LDS_WAIT(); asm volatile("" ::: "memory");
}
__device__ __forceinline__ void tr_job(const Frame& F, LAS float* scr, const float* W, int K, int N, bf16* WT, int ldo, int mode, int& it_base) {
    const int NGW = F.G * NWAVES, gw = F.bid * NWAVES + F.wave;
    const int n = (K / 64) * (N / 32);
    int first = (gw - (it_base % NGW) + NGW) % NGW;
    for (int idx = first; idx < n; idx += NGW) tr_item(W, K, N, WT, ldo, mode, scr, idx, F.lane);
    it_base += n;
}
__device__ __forceinline__ void convert_layer_main(const Frame& F, const Args& a, int l) {
    LAS float* scr = (LAS float*)(F.lds + F.wave * 16384);
    int base = 0;
    tr_job(F, scr, a.in[I_W_IN] + (size_t)l * D * INW, D, INW, (bf16*)(F.ws + WS_WINT), D, 0, base);
    tr_job(F, scr, a.in[I_P_A] + (size_t)l * AW * D, AW, D, (bf16*)(F.ws + WS_PT) + OC_U, LDO, 0, base);
    tr_job(F, scr, a.in[I_P_B] + (size_t)l * BW * D, BW, D, (bf16*)(F.ws + WS_PT) + OC_GB, LDO, 0, base);
    tr_job(F, scr, a.in[I_P_C] + (size_t)l * CW * D, CW, D, (bf16*)(F.ws + WS_PT) + OC_Q, LDO, 0, base);
    tr_job(F, scr, a.in[I_W_O] + (size_t)l * D * D, D, D, (bf16*)(F.ws + WS_WOT), D, 0, base);
}
__device__ __forceinline__ void convert_layer_moe(const Frame& F, const Args& a, int l) {
    LAS float* scr = (LAS float*)(F.lds + F.wave * 16384);
    int base = 0;
    for (int e = 0; e < NEXP; ++e) tr_job(F, scr, a.in[I_W_UP] + (size_t)(l * NEXP + e) * D * 512, D, 512, (bf16*)(F.ws + WS_WUPT) + (size_t)e * 512 * D, D, 1, base);
    for (int e = 0; e < NEXP; ++e) tr_job(F, scr, a.in[I_W_DOWN] + (size_t)(l * NEXP + e) * DEXP * D, DEXP, D, (bf16*)(F.ws + WS_WDNT) + (size_t)e * D * DEXP, DEXP, 0, base);
}
__device__ __forceinline__ void ln_row_store(f32x4 (&v)[4], int lane, const float* g, const float* b, float* o32, bf16* o16) {
    float s = 0.f;
#pragma unroll
    for (int j = 0; j < 4; ++j) s += (v[j].x + v[j].y) + (v[j].z + v[j].w);
    const float mean = wave_sum(s) * (1.f / 1024.f); float s2 = 0.f;
#pragma unroll
    for (int j = 0; j < 4; ++j) { v[j] = v[j] - mean; s2 += (v[j].x * v[j].x + v[j].y * v[j].y) + (v[j].z * v[j].z + v[j].w * v[j].w); }
    const float rstd = 1.f / sqrtf(wave_sum(s2) * (1.f / 1024.f) + LN_EPS);
#pragma unroll
    for (int j = 0; j < 4; ++j) { const f32x4 gv = ((const f32x4*)g)[64 * j + lane], bv = ((const f32x4*)b)[64 * j + lane]; const f32x4 o = v[j] * rstd * gv + bv;
        if (o32) ((f32x4*)o32)[64 * j + lane] = o;
        if (o16) ((v2u*)o16)[64 * j + lane] = (v2u){pk2(o.x, o.y), pk2(o.z, o.w)}; }
}

struct SchedDense {
    const char* A; const char* Bt; int K, ld, nM, nN, nwg, G, c;
    __device__ void init(const void* A_, const void* Bt_, int K_, int M_, int N_, int G_, int c_) { A = (const char*)A_; Bt = (const char*)Bt_; K = K_; ld = K_; nM = M_ / 256; nN = N_ / 256; nwg = nM * nN; G = G_; c = c_; }
    __device__ __forceinline__ bool next(int i, pg8::Unit& u) const {
        const long L = (long)i * G + c; if (L >= nwg) return false;
        int wgid = (int)L; { const int q = nwg / 8, r = nwg % 8, xcd = wgid % 8, off = wgid / 8; wgid = (xcd < r ? xcd * (q + 1) : r * (q + 1) + (xcd - r) * q) + off; }
        const int nig = 8 * nN, gid = wgid / nig, fm = gid * 8, gsz = (nM - fm) < 8 ? (nM - fm) : 8;
        u.pm = fm + ((wgid % nig) % gsz); u.pn = (wgid % nig) / gsz; u.K = K; u.seg = 0;
        u.A = A + (size_t)u.pm * 256 * K * 2; u.B = Bt + (size_t)u.pn * 256 * K * 2; return true;
    }
    __device__ __forceinline__ void a_ready(const pg8::Unit&) const {}
    __device__ __forceinline__ void done(const pg8::Unit&) const {}
};
struct SchedKV {
    const char* A; const char* Bt; int G, c; static constexpr int ld = D;
    __device__ __forceinline__ bool next(int i, pg8::Unit& u) const {
        const int L = i * G + (G - 1 - c); if (L >= 64) return false;
        u.seg = L >> 5; u.pm = (L & 31) & 3; u.pn = (L & 31) >> 2; u.K = D;
        u.A = A + (size_t)u.pm * 256 * D * 2; u.B = Bt + ((size_t)u.seg * 2048 + (size_t)u.pn * 256) * D * 2; return true;
    }
    __device__ __forceinline__ void a_ready(const pg8::Unit&) const {}
    __device__ __forceinline__ void done(const pg8::Unit&) const {}
};
struct SchedY {
    const char *A, *B; int pm, pn; bool ok; static constexpr int ld = LDO;
    __device__ void init(const unsigned char* ws, int G, int c) { SchedDense s; s.init(nullptr, nullptr, D, M, D, G, c); pg8::Unit u; ok = s.next(0, u) && G == 256; pm = u.pm; pn = u.pn;
        A = (const char*)(ws + WS_O) + (size_t)pm * 256 * LDO * 2; B = (const char*)(ws + WS_PT) + (size_t)pn * 256 * LDO * 2; }
    __device__ __forceinline__ bool next(int i, pg8::Unit& u) const {
        if (!ok || i >= 3) return false;
        const int k0 = (i == 0) ? OC_U : (i == 1) ? OC_GB : OC_Q;
        u.pm = pm; u.pn = pn; u.seg = i; u.K = (i == 1) ? BW : 1024; u.A = A + k0 * 2; u.B = B + k0 * 2; return true;
    }
    __device__ __forceinline__ void a_ready(const pg8::Unit&) const {}
    __device__ __forceinline__ void done(const pg8::Unit&) const {}
};
struct SchedMoE {
    const char* A; int K; const char* W; size_t wstride; int ncol; gu32* cnt; int G, c; int ld;
    __device__ __forceinline__ bool next(int i, pg8::Unit& u) const {
        const int L = i * G + c, rt = L / ncol, pn = L % ncol;
        int acc = 0, e = -1;
#pragma unroll 1
        for (int k = 0; k < NEXP; ++k) { const int n = (int)((__hip_atomic_load(cnt + 64 * k, RLX_AGENT) + 255u) >> 8); if (e < 0 && rt < acc + n) e = k; acc += n; }
        e = __builtin_amdgcn_readfirstlane(e);
        if (e < 0) return false;
        u.pm = rt; u.pn = pn; u.seg = e; u.K = K;
        u.A = A + (size_t)rt * 256 * K * 2; u.B = W + (size_t)e * wstride + (size_t)pn * 256 * K * 2; return true;
    }
    __device__ __forceinline__ void a_ready(const pg8::Unit&) const {}
    __device__ __forceinline__ void done(const pg8::Unit&) const {}
};

using pg8::f32x2; using pg8::u32x4; using pg8::u32x2; using pg8::Unit; using pg8::HALF;
struct EpiInProj {
    static constexpr bool PERM = true, AFTER_DRAIN = false, KEEP = false;
    bf16 *O_, *V, *XBR; const float* bias;
    __device__ __forceinline__ bool operator()(f32x4 (&acc)[2][2][4][2], const Unit& u, int wr, int wc, int fr, int fq) const {
        const int t = u.pn; bf16* O; int ldc, ct, act; float sc = 1.f;
        if (t < 4) { O = O_ + OC_U; ldc = LDO; ct = t; act = 1; }
        else if (t < 8) { O = V; ldc = 1024; ct = t - 4; act = 1; }
        else if (t < 13) { O = XBR; ldc = BW; ct = t - 8; act = 0; }
        else if (t < 18) { O = O_ + OC_GB; ldc = LDO; ct = t - 13; act = 1; }
        else { O = O_ + OC_Q; ldc = LDO; ct = t - 18; act = 0; sc = 0.0625f; }
        bf16* tile = O + (size_t)u.pm * 256 * ldc + ct * 256; const float* b = bias + t * 256;
        if (act == 1) pg8::store_tile_bf16<1>(acc, tile, ldc, b, sc, wr, wc, fr, fq); else pg8::store_tile_bf16<0>(acc, tile, ldc, b, sc, wr, wc, fr, fq);
        return false;
    }
};
struct EpiGate {
    static constexpr bool PERM = true, AFTER_DRAIN = false, KEEP = false;
    bf16* G0; const float* bias;
    __device__ __forceinline__ bool operator()(f32x4 (&acc)[2][2][4][2], const Unit& u, int wr, int wc, int fr, int fq) const {
        const int t = u.pn; bf16* tile = G0 + (size_t)(t >> 2) * ((size_t)M * 1024) + (size_t)u.pm * 256 * 1024 + (t & 3) * 256;
        pg8::store_tile_bf16<2>(acc, tile, 1024, bias + t * 256, 1.f, wr, wc, fr, fq); return false;
    }
};
struct EpiKV {
    static constexpr bool PERM = true, AFTER_DRAIN = false, KEEP = false;
    bf16* KV;
    __device__ __forceinline__ bool operator()(f32x4 (&acc)[2][2][4][2], const Unit& u, int wr, int wc, int fr, int fq) const {
        bf16* tile = KV + ((size_t)u.seg * 1024 + (size_t)u.pm * 256) * 2048 + u.pn * 256;
        pg8::store_tile_bf16<0>(acc, tile, 2048, nullptr, 1.f, wr, wc, fr, fq); return false;
    }
};
struct EpiPlain {
    static constexpr bool PERM = true, AFTER_DRAIN = false, KEEP = false;
    bf16* O; int ldc;
    __device__ __forceinline__ bool operator()(f32x4 (&acc)[2][2][4][2], const Unit& u, int wr, int wc, int fr, int fq) const {
        pg8::store_tile_bf16<0>(acc, O + (size_t)u.pm * 256 * ldc + u.pn * 256, ldc, nullptr, 1.f, wr, wc, fr, fq); return false;
    }
};
struct EpiY {
    static constexpr bool PERM = true, AFTER_DRAIN = false, KEEP = true;
    const bf16 *GA, *GB_, *GC; bf16* Y;
    __device__ __forceinline__ bool operator()(f32x4 (&acc)[2][2][4][2], const Unit& u, int wr, int wc, int fr, int fq) const {
        int pm_ = u.pm, pn_ = u.pn; asm volatile("" : "+s"(pm_), "+s"(pn_));
        const unsigned t0 = (unsigned)(pm_ * 256 * 1024 + pn_ * 256 + wc * 32 + 8 * fq);
        const bool fin = (u.seg == 2);
        const GAS bf16* num = (const GAS bf16*)((u.seg == 0) ? GA : (u.seg == 1) ? GB_ : GC); const GAS bf16* den = (const GAS bf16*)((u.seg == 0) ? GB_ : GC);
#pragma unroll
        for (int ai = 0; ai < 2; ++ai)
#pragma unroll
            for (int m = 0; m < 4; ++m) { const unsigned ro = t0 + (unsigned)(ai * HALF + wr * 64 + m * 16 + fr) * 1024u;
#pragma unroll
                for (int bj = 0; bj < 2; ++bj) {
                    const u32x4 nw = *(const GAS u32x4*)(num + ro + bj * HALF); const u32x4 dw = *(const GAS u32x4*)(den + ro + bj * HALF);
#define EPIY_F(nv, dv) ((nv) * (fin ? 1.0f : __builtin_amdgcn_rcpf(fmaxf((dv), 1e-6f))))
                    acc[ai][bj][m][0][0] *= EPIY_F(bf_lo(nw.x), bf_lo(dw.x)); acc[ai][bj][m][0][1] *= EPIY_F(bf_hi(nw.x), bf_hi(dw.x));
                    acc[ai][bj][m][0][2] *= EPIY_F(bf_lo(nw.y), bf_lo(dw.y)); acc[ai][bj][m][0][3] *= EPIY_F(bf_hi(nw.y), bf_hi(dw.y));
                    acc[ai][bj][m][1][0] *= EPIY_F(bf_lo(nw.z), bf_lo(dw.z)); acc[ai][bj][m][1][1] *= EPIY_F(bf_hi(nw.z), bf_hi(dw.z));
                    acc[ai][bj][m][1][2] *= EPIY_F(bf_lo(nw.w), bf_lo(dw.w)); acc[ai][bj][m][1][3] *= EPIY_F(bf_hi(nw.w), bf_hi(dw.w));
#undef EPIY_F
                }
                asm volatile("" ::: "memory"); }
        if (fin) {
            GAS bf16* Yg = (GAS bf16*)Y;
#pragma unroll
            for (int ai = 0; ai < 2; ++ai)
#pragma unroll
                for (int m = 0; m < 4; ++m) { const unsigned ro = t0 + (unsigned)(ai * HALF + wr * 64 + m * 16 + fr) * 1024u;
#pragma unroll
                    for (int bj = 0; bj < 2; ++bj) { const f32x4 v0 = acc[ai][bj][m][0], v1 = acc[ai][bj][m][1];
                        u32x4 w; w.x = pg8::cvt_pk_bf16(v0[0], v0[1]); w.y = pg8::cvt_pk_bf16(v0[2], v0[3]); w.z = pg8::cvt_pk_bf16(v1[0], v1[1]); w.w = pg8::cvt_pk_bf16(v1[2], v1[3]);
                        *(GAS u32x4*)(Yg + ro + bj * HALF) = w; } }
        }
        return !fin;
    }
};
struct EpiLn {
    static constexpr bool PERM = false, AFTER_DRAIN = true, KEEP = false;
    float* X; bf16* XBo; const float *bias, *g, *b; pg8::PanelStats st; unsigned poison;
    __device__ __forceinline__ void fused(f32x4 (&acc)[2][2][4][2], const Unit& u, int wr, int wc, int fr, int fq, PG8_LAS unsigned char* lds, int wid, int lane) const {
        typedef float f32x2v __attribute__((ext_vector_type(2)));
        const PG8_LAS f32x2v* S = (const PG8_LAS f32x2v*)(lds + 8192);
        const int col0 = u.pn * 256 + wc * 32 + 4 * fq;
#pragma unroll
        for (int ai = 0; ai < 2; ++ai)
#pragma unroll
            for (int m = 0; m < 4; ++m) { const unsigned off = (unsigned)(u.pm * 256 + ai * HALF + wr * 64 + m * 16 + fr) * 1024u + col0;
#pragma unroll
                for (int bj = 0; bj < 2; ++bj)
#pragma unroll
                    for (int n = 0; n < 2; ++n) { const f32x4 xs = *(const f32x4*)(X + off + bj * HALF + n * 16); const f32x4 bv = *(const f32x4*)(bias + col0 + bj * HALF + n * 16);
                        acc[ai][bj][m][n] = acc[ai][bj][m][n] + bv + xs * ALPHA; }
                asm volatile("" : "+v"(acc[ai][0][m][0]), "+v"(acc[ai][0][m][1]), "+v"(acc[ai][1][m][0]), "+v"(acc[ai][1][m][1]));
                if (m & 1) asm volatile("" ::: "memory"); }
        const bool bad = st.run(acc, u, wr, wc, fr, fq, lds, wid, lane) || poison != 0u;
        const float qnan = __builtin_nanf("");
#pragma unroll
        for (int bj = 0; bj < 2; ++bj)
#pragma unroll
            for (int n = 0; n < 2; ++n) { const f32x4 gv = *(const f32x4*)(g + col0 + bj * HALF + n * 16), bb = *(const f32x4*)(b + col0 + bj * HALF + n * 16);
#pragma unroll
                for (int ai = 0; ai < 2; ++ai)
#pragma unroll
                    for (int m = 0; m < 4; ++m) { const int r = ai * HALF + wr * 64 + m * 16 + fr; const f32x2v sr = S[r]; const unsigned off = (unsigned)(u.pm * 256 + r) * 1024u + col0 + bj * HALF + n * 16;
                        f32x4 o = (acc[ai][bj][m][n] - sr.x) * sr.y * gv + bb; if (bad) o = (f32x4){qnan, qnan, qnan, qnan};
                        *(f32x4*)(X + off) = o; *(u32x2*)(XBo + off) = (u32x2){pg8::cvt_pk_bf16(o[0], o[1]), pg8::cvt_pk_bf16(o[2], o[3])}; } }
    }
};
struct EpiF32Res {
    static constexpr bool PERM = false, AFTER_DRAIN = false, KEEP = false;
    const float* X; float* T; const float* bias;
    __device__ __forceinline__ bool operator()(f32x4 (&acc)[2][2][4][2], const Unit& u, int wr, int wc, int fr, int fq) const {
        const int col0 = u.pn * 256 + wc * 32 + 4 * fq;
#pragma unroll
        for (int ai = 0; ai < 2; ++ai)
#pragma unroll
            for (int m = 0; m < 4; ++m) { const unsigned off = (unsigned)(u.pm * 256 + ai * HALF + wr * 64 + m * 16 + fr) * 1024u + col0;
#pragma unroll
                for (int bj = 0; bj < 2; ++bj)
#pragma unroll
                    for (int n = 0; n < 2; ++n) { const f32x4 xs = *(const f32x4*)(X + off + bj * HALF + n * 16); const f32x4 bv = *(const f32x4*)(bias + col0 + bj * HALF + n * 16);
                        *(f32x4*)(T + off + bj * HALF + n * 16) = acc[ai][bj][m][n] + bv + xs * ALPHA; }
                asm volatile("" ::: "memory"); }
        return false;
    }
};
struct EpiUp {
    static constexpr bool PERM = true, AFTER_DRAIN = false, KEEP = false;
    const float* ROWW; bf16* H;
    __device__ __forceinline__ bool operator()(f32x4 (&acc)[2][2][4][2], const Unit& u, int wr, int wc, int fr, int fq) const {
        const int c0 = u.pn * 128 + wc * 32 + 8 * fq;
#pragma unroll
        for (int ai = 0; ai < 2; ++ai)
#pragma unroll
            for (int m = 0; m < 4; ++m) { const unsigned row = (unsigned)(u.pm * 256 + ai * HALF + wr * 64 + m * 16 + fr); const float w = ROWW[row];
                float h[8];
#pragma unroll
                for (int n = 0; n < 2; ++n)
#pragma unroll
                    for (int e = 0; e < 4; ++e) { const float gv = acc[ai][0][m][n][e], uv = acc[ai][1][m][n][e]; h[n * 4 + e] = gv * pg8::fast_sigmoid(gv) * uv * w; }
                u32x4 o; o.x = pg8::cvt_pk_bf16(h[0], h[1]); o.y = pg8::cvt_pk_bf16(h[2], h[3]); o.z = pg8::cvt_pk_bf16(h[4], h[5]); o.w = pg8::cvt_pk_bf16(h[6], h[7]);
                *(u32x4*)(H + row * DEXP + c0) = o; }
        return false;
    }
};

__device__ __forceinline__ void unpack8(const v4u w, float* f) { f[0] = bf_lo(w.x); f[1] = bf_hi(w.x); f[2] = bf_lo(w.y); f[3] = bf_hi(w.y); f[4] = bf_lo(w.z); f[5] = bf_hi(w.z); f[6] = bf_lo(w.w); f[7] = bf_hi(w.w); }

__device__ __forceinline__ void ph_prologue(const Frame& F, const Args& a) {
    convert_layer_main(F, a, 0);
    { LAS float* scr = (LAS float*)(F.lds + F.wave * 16384); int base = 0;
      for (int l = 0; l < DEPTH; ++l) tr_job(F, scr, a.in[I_W_KV] + (size_t)l * D * 2048, D, 2048, (bf16*)(F.ws + WS_WKVT) + (size_t)l * 2048 * D, D, 0, base); }
    const int gw = F.bid * NWAVES + F.wave, NGW = F.G * NWAVES;
    for (int m = gw; m < M + NB * NMEM; m += NGW) {
        const bool is_x = m < M; const int r = is_x ? m : m - M;
        const float* src = (is_x ? a.in[I_X] : a.in[I_MEM]) + (size_t)r * D;
        f32x4 v[4];
#pragma unroll
        for (int j = 0; j < 4; ++j) v[j] = ((const f32x4*)src)[64 * j + F.lane];
        if (is_x) ln_row_store(v, F.lane, a.in[I_LN_IN_G], a.in[I_LN_IN_B], a.out + (size_t)r * D, (bf16*)(F.ws + WS_XB) + (size_t)r * D);
        else ln_row_store(v, F.lane, a.in[I_LN_MEM_G], a.in[I_LN_MEM_B], nullptr, (bf16*)(F.ws + WS_MEMN) + (size_t)r * D);
    }
}

__device__ __forceinline__ void item_spatial(const Frame& F, const Args& a, int l, int item) {
    const int g = item & 7, bc = item >> 3; const size_t row0 = (size_t)bc * 128;
    const bf16* V = (const bf16*)(F.ws + WS_V); bf16* U = (bf16*)(F.ws + WS_O) + OC_U;
    LAS float* stat = (LAS float*)F.lds;
    LAS float* vn = (LAS float*)(F.lds + 1024);
    for (int i = 0; i < 16; ++i) { const int t = F.wave * 16 + i; const bf16* vr = V + (row0 + t) * 1024;
        float x[16]; unpack8(*(const v4u*)(vr + F.lane * 8), x); unpack8(*(const v4u*)(vr + 512 + F.lane * 8), x + 8);
        float s = 0.f;
#pragma unroll
        for (int e = 0; e < 16; ++e) s += x[e];
        const float mean = wave_sum(s) * (1.f / 1024.f); float q = 0.f;
#pragma unroll
        for (int e = 0; e < 16; ++e) { const float d = x[e] - mean; q += d * d; }
        const float rstd = 1.f / sqrtf(wave_sum(q) * (1.f / 1024.f) + LN_EPS);
        if (F.lane == 0) { stat[2 * t] = mean; stat[2 * t + 1] = rstd; } }
    __syncthreads();
    { const int d = F.tid & 127; const float gg = a.in[I_LN_V_G][l * AW + g * 128 + d], bb = a.in[I_LN_V_B][l * AW + g * 128 + d];
      for (int i = 0; i < 32; ++i) { const int s = (F.tid >> 7) + 4 * i; const float v = bf2f(V[(row0 + s) * 1024 + g * 128 + d]); vn[s * 128 + d] = (v - stat[2 * s]) * stat[2 * s + 1] * gg + bb; } }
    __syncthreads();
    { const int d = F.tid & 127, tq = F.tid >> 7; const float* ws_ = a.in[I_W_S] + (size_t)(l * 8 + g) * 128 * 128; const float* bs_ = a.in[I_B_S] + (l * 8 + g) * 128;
      for (int t = tq * 32; t < tq * 32 + 32; ++t) { const float* wrow = ws_ + t * 128; float acc = 0.f;
          for (int s = 0; s <= t; ++s) acc += wrow[s] * vn[s * 128 + d];
          const size_t idx = (row0 + t) * LDO + g * 128 + d; U[idx] = DBG_ZA ? (bf16)0 : (bf16)f2bf(bf2f(U[idx]) * (acc + bs_[t])); } }
    __syncthreads();
}

__device__ __forceinline__ void item_attn(const Frame& F, int l, int item) {
    const int tile = item & 63, bh = item >> 6, h = bh & 3, b = bh >> 2, lane = F.lane;
    LAS float* qs = (LAS float*)F.lds + F.wave * 2048;
    LAS float* ps = qs + 1024;
    const bf16* Kb = (const bf16*)(F.ws + WS_KV) + ((size_t)l * 1024 + b * 256) * 2048 + h * 256; const bf16* Vb = Kb + 1024;
    bf16* Q = (bf16*)(F.ws + WS_O) + OC_Q;
    for (int tg = 0; tg < 2; ++tg) {
        const size_t row = (size_t)b * SEQ + tile * 64 + F.wave * 8 + tg * 4;
        { const int tk = lane >> 4, d0 = (lane & 15) * 16; const bf16* qp = Q + (row + tk) * LDO + h * 256 + d0; float x[16]; unpack8(*(const v4u*)qp, x); unpack8(*(const v4u*)(qp + 8), x + 8);
#pragma unroll
          for (int e = 0; e < 16; ++e) qs[tk * 256 + d0 + e] = x[e]; }
        LDS_WAIT(); asm volatile("" ::: "memory");
        float s[4][4];
#pragma unroll
        for (int tk = 0; tk < 4; ++tk)
#pragma unroll
            for (int j = 0; j < 4; ++j) s[tk][j] = 0.f;
        for (int d0 = 0; d0 < 256; d0 += 8) {
            float kv[4][8];
#pragma unroll
            for (int j = 0; j < 4; ++j) unpack8(*(const v4u*)(Kb + (size_t)(lane + 64 * j) * 2048 + d0), kv[j]);
#pragma unroll
            for (int tk = 0; tk < 4; ++tk) { const f32x4 q0 = *(const LAS f32x4*)(qs + tk * 256 + d0), q1 = *(const LAS f32x4*)(qs + tk * 256 + d0 + 4);
#pragma unroll
                for (int j = 0; j < 4; ++j) s[tk][j] += (q0[0] * kv[j][0] + q0[1] * kv[j][1]) + (q0[2] * kv[j][2] + q0[3] * kv[j][3]) + (q1[0] * kv[j][4] + q1[1] * kv[j][5]) + (q1[2] * kv[j][6] + q1[3] * kv[j][7]); }
        }
#pragma unroll
        for (int tk = 0; tk < 4; ++tk) { float mx = fmaxf(fmaxf(s[tk][0], s[tk][1]), fmaxf(s[tk][2], s[tk][3])); mx = wave_max(mx);
            float e[4], sum = 0.f;
#pragma unroll
            for (int j = 0; j < 4; ++j) { e[j] = __expf(s[tk][j] - mx); sum += e[j]; }
            sum = wave_sum(sum); const float inv = 1.f / sum;
#pragma unroll
            for (int j = 0; j < 4; ++j) ps[tk * 256 + lane + 64 * j] = e[j] * inv; }
        LDS_WAIT(); asm volatile("" ::: "memory");
        float o[4][4];
#pragma unroll
        for (int tk = 0; tk < 4; ++tk)
#pragma unroll
            for (int e = 0; e < 4; ++e) o[tk][e] = 0.f;
        for (int k = 0; k < 256; k += 4) {
            float v[4][4];
#pragma unroll
            for (int kk = 0; kk < 4; ++kk) { const v2u w = *(const v2u*)(Vb + (size_t)(k + kk) * 2048 + 4 * lane); v[kk][0] = bf_lo(w.x); v[kk][1] = bf_hi(w.x); v[kk][2] = bf_lo(w.y); v[kk][3] = bf_hi(w.y); }
#pragma unroll
            for (int tk = 0; tk < 4; ++tk) { const f32x4 p4 = *(const LAS f32x4*)(ps + tk * 256 + k);
#pragma unroll
                for (int kk = 0; kk < 4; ++kk)
#pragma unroll
                    for (int e = 0; e < 4; ++e) o[tk][e] += p4[kk] * v[kk][e]; }
        }
#pragma unroll
        for (int tk = 0; tk < 4; ++tk) *(v2u*)(Q + (row + tk) * LDO + h * 256 + 4 * lane) = DBG_ZC ? (v2u){0u, 0u} : (v2u){pk2(o[tk][0], o[tk][1]), pk2(o[tk][2], o[tk][3])};
        LDS_WAIT(); asm volatile("" ::: "memory");
    }
}

__device__ __forceinline__ void item_lru(const Frame& F, const Args& a, int l, int item, int pass) {
    const int h = item % 10, b = (item / 10) & 3, c = item / 40, ch = h * 128 + (F.tid & 127), j = F.tid & 127, tq = F.tid >> 7;
    LAS float* cx = (LAS float*)F.lds; LAS float* As = cx + 8192; LAS float* Bs = As + 8192;
    const float* wa = a.in[I_W_A] + (size_t)(l * 10 + h) * 128 * 128; const float* wx = a.in[I_W_X] + (size_t)(l * 10 + h) * 128 * 128;
    const float ba = a.in[I_B_A][l * BW + ch], bxb = a.in[I_B_X][l * BW + ch], sp = log1pf(expf(-a.in[I_LAM][l * BW + ch]));
    const float cw0 = a.in[I_CONV_W][(l * 4 + 0) * BW + ch], cw1 = a.in[I_CONV_W][(l * 4 + 1) * BW + ch], cw2 = a.in[I_CONV_W][(l * 4 + 2) * BW + ch], cw3 = a.in[I_CONV_W][(l * 4 + 3) * BW + ch], cb = a.in[I_CONV_B][l * BW + ch];
    const bf16* XBR = (const bf16*)(F.ws + WS_XBR) + (size_t)b * SEQ * BW + ch; bf16* GB = (bf16*)(F.ws + WS_O) + OC_GB + (size_t)b * SEQ * LDO + ch;
    float* SUMM = (float*)(F.ws + WS_SUMM);
    float hst = 0.f, P = 1.f;
    if (pass == 2 && tq == 0) for (int cc = 0; cc < c; ++cc) { const float a_ = SUMM[((size_t)(b * 32 + cc) * BW + ch) * 2], h_ = SUMM[((size_t)(b * 32 + cc) * BW + ch) * 2 + 1]; hst = a_ * hst + h_; }
    for (int half = 0; half < 2; ++half) {
        const int tbase = c * 128 + half * 64;
        for (int tt = 0; tt < 16; ++tt) { const int t = tq * 16 + tt, pos = tbase + t; float acc = cb;
            if (pos >= 3) acc += cw0 * bf2f(XBR[(size_t)(pos - 3) * BW]);
            if (pos >= 2) acc += cw1 * bf2f(XBR[(size_t)(pos - 2) * BW]);
            if (pos >= 1) acc += cw2 * bf2f(XBR[(size_t)(pos - 1) * BW]);
            acc += cw3 * bf2f(XBR[(size_t)pos * BW]);
            cx[t * 128 + j] = acc; }
        __syncthreads();
        float ra[16], rx[16];
#pragma unroll
        for (int tt = 0; tt < 16; ++tt) { ra[tt] = 0.f; rx[tt] = 0.f; }
        for (int i = 0; i < 128; ++i) { const float wai = wa[i * 128 + j], wxi = wx[i * 128 + j];
#pragma unroll
            for (int tt = 0; tt < 16; ++tt) { const float cv = cx[(tq * 16 + tt) * 128 + i]; ra[tt] += cv * wai; rx[tt] += cv * wxi; } }
#pragma unroll
        for (int tt = 0; tt < 16; ++tt) { const int t = tq * 16 + tt; const float r = 1.f / (1.f + expf(-(ra[tt] + ba))), ii = 1.f / (1.f + expf(-(rx[tt] + bxb)));
            const float la = -8.0f * r * sp, av = expf(la), mult = sqrtf(-expm1f(2.f * la)); As[t * 128 + j] = av; Bs[t * 128 + j] = mult * ii * cx[t * 128 + j]; }
        __syncthreads();
        if (tq == 0) for (int t = 0; t < 64; ++t) { const float av = As[t * 128 + j]; hst = av * hst + Bs[t * 128 + j]; P *= av;
            if (pass == 2) { const size_t idx = (size_t)(tbase + t) * LDO; GB[idx] = DBG_ZB ? (bf16)0 : (bf16)f2bf(hst * bf2f(GB[idx])); } }
        __syncthreads();
    }
    if (pass == 1 && tq == 0) { SUMM[((size_t)(b * 32 + c) * BW + ch) * 2] = P; SUMM[((size_t)(b * 32 + c) * BW + ch) * 2 + 1] = hst; }
}

__device__ __forceinline__ void ph_router(const Frame& F, const Args& a, int l, const bf16*  ) {
    LAS int* s_e = (LAS int*)F.lds; LAS float* s_w = (LAS float*)(F.lds + 512); LAS int* s_cnt = (LAS int*)(F.lds + 1024); LAS int* s_base = s_cnt + 16;
    const float* wrg = a.in[I_W_RG] + (size_t)l * D * 4; const float* wre = a.in[I_W_RE] + (size_t)l * D * 16; const float* brg = a.in[I_B_RG] + l * 4; const float* bre = a.in[I_B_RE] + l * 16;
    int* EID = (int*)(F.ws + WS_META); int* POS = EID + NPAIR; float* WGT = (float*)(POS + NPAIR);
    gu32* gcnt = F.ctl + CW_MOE + l * 16 * 64;
    for (int tb = F.bid; tb < M / 64; tb += F.G) {
        if (F.tid < 16) s_cnt[F.tid] = 0;
        for (int i = 0; i < 8; ++i) { const int tok = tb * 64 + F.wave * 8 + i; const float* xr = a.out + (size_t)tok * D;
            float lg[20];
#pragma unroll
            for (int o = 0; o < 20; ++o) lg[o] = 0.f;
#pragma unroll 2
            for (int i2 = 0; i2 < 16; ++i2) { const int d = 64 * i2 + F.lane; const float x = xr[d];
                const f32x4 g4 = *(const f32x4*)(wrg + d * 4);
#pragma unroll
                for (int o = 0; o < 4; ++o) lg[o] += x * g4[o];
#pragma unroll
                for (int q = 0; q < 4; ++q) { const f32x4 e4 = *(const f32x4*)(wre + d * 16 + 4 * q);
#pragma unroll
                    for (int o = 0; o < 4; ++o) lg[4 + 4 * q + o] += x * e4[o]; } }
#pragma unroll
            for (int o = 0; o < 20; ++o) lg[o] = wave_sum(lg[o]);
            if (F.lane == 0) {
                float gl[4]; int gt = 0;
#pragma unroll
                for (int o = 0; o < 4; ++o) gl[o] = lg[o] + brg[o];
                float gm = gl[0];
#pragma unroll
                for (int o = 1; o < 4; ++o) if (gl[o] > gm) { gm = gl[o]; gt = o; }
                float gs = 0.f;
#pragma unroll
                for (int o = 0; o < 4; ++o) gs += expf(gl[o] - gm);
                const float ptop = 1.f / gs;
                float el[4];
#pragma unroll
                for (int o = 0; o < 4; ++o) { float v = 0.f;
#pragma unroll
                    for (int q = 0; q < 4; ++q) v = (gt == q) ? lg[4 + 4 * q + o] + bre[4 * q + o] : v;
                    el[o] = v; }
                int i1 = 0;
#pragma unroll
                for (int o = 1; o < 4; ++o) if (el[o] > el[i1]) i1 = o;
                int i2 = (i1 == 0) ? 1 : 0;
#pragma unroll
                for (int o = 0; o < 4; ++o) if (o != i1 && o != i2 && el[o] > el[i2]) i2 = o;
                const float e1 = 1.f, e2 = expf(el[i2] - el[i1]); const float inv = ptop / (e1 + e2);
                const int p = (F.wave * 8 + i) * 2;
                s_e[p] = gt * 4 + i1; s_w[p] = e1 * inv; s_e[p + 1] = gt * 4 + i2; s_w[p + 1] = e2 * inv;
            } }
        __syncthreads();
        int mye = 0, mypos = 0;
        if (F.tid < 128) { mye = s_e[F.tid]; for (int q = 0; q < F.tid; ++q) mypos += (s_e[q] == mye) ? 1 : 0; atomicAdd((int*)&s_cnt[mye], 1); }
        __syncthreads();
        if (F.tid < 16) s_base[F.tid] = (int)__hip_atomic_fetch_add(gcnt + 64 * F.tid, (unsigned)s_cnt[F.tid], RLX_AGENT);
        __syncthreads();
        if (F.tid < 128) { const int p = tb * 128 + F.tid; EID[p] = mye; POS[p] = s_base[mye] + mypos; WGT[p] = s_w[F.tid]; }
        __syncthreads();
    }
}
__device__ __forceinline__ void ph_gather(const Frame& F, int l) {
    const int* EID = (const int*)(F.ws + WS_META); const int* POS = EID + NPAIR; const float* WGT = (const float*)(POS + NPAIR); int* ROWOF = (int*)(WGT + NPAIR); float* ROWW = (float*)(ROWOF + NPAIR);
    gu32* gcnt = F.ctl + CW_MOE + l * 16 * 64;
    const bf16* X1B = (const bf16*)(F.ws + WS_X1B); bf16* XG = (bf16*)(F.ws + WS_XG);
    const int gw = F.bid * NWAVES + F.wave, NGW = F.G * NWAVES;
    for (int p = gw; p < NPAIR; p += NGW) {
        const int e = EID[p]; int off = 0;
        for (int k = 0; k < NEXP; ++k) { const int n = (int)((__hip_atomic_load(gcnt + 64 * k, RLX_AGENT) + 255u) & ~255u); off += (k < e) ? n : 0; }
        const int row = off + POS[p];
        const v4u* src = (const v4u*)(X1B + (size_t)(p >> 1) * D); v4u* dst = (v4u*)(XG + (size_t)row * D);
        dst[F.lane] = src[F.lane]; dst[64 + F.lane] = src[64 + F.lane];
        if (F.lane == 0) { ROWOF[p] = row; ROWW[row] = WGT[p]; }
    }
}
__device__ __forceinline__ void ph_combine(const Frame& F, const Args& a, int l) {
    const int* ROWOF = (const int*)(F.ws + WS_META) + 3 * NPAIR; const bf16* F2 = (const bf16*)(F.ws + WS_F2);
    const int gw = F.bid * NWAVES + F.wave, NGW = F.G * NWAVES;
    for (int m = gw; m < M; m += NGW) {
        const int r0 = ROWOF[2 * m], r1 = ROWOF[2 * m + 1];
        f32x4 v[4];
#pragma unroll
        for (int j = 0; j < 4; ++j) { const f32x4 x = ((const f32x4*)(a.out + (size_t)m * D))[64 * j + F.lane];
            const v2u w0 = ((const v2u*)(F2 + (size_t)r0 * D))[64 * j + F.lane], w1 = ((const v2u*)(F2 + (size_t)r1 * D))[64 * j + F.lane];
            v[j] = x * ALPHA + ((f32x4){bf_lo(w0.x), bf_hi(w0.x), bf_lo(w0.y), bf_hi(w0.y)} + (f32x4){bf_lo(w1.x), bf_hi(w1.x), bf_lo(w1.y), bf_hi(w1.y)}) * DBG_FSCALE; }
        ln_row_store(v, F.lane, a.in[I_LN2_G] + l * D, a.in[I_LN2_B] + l * D, a.out + (size_t)m * D, (bf16*)(F.ws + WS_XB) + (size_t)m * D);
    }
}

__device__ __forceinline__ void ph_ln1(const Frame& F, const Args& a, int l) {
    const float* T = (const float*)(F.ws + WS_F2);
    const int gw = F.bid * NWAVES + F.wave, NGW = F.G * NWAVES;
    for (int m = gw; m < M; m += NGW) {
        f32x4 v[4];
#pragma unroll
        for (int j = 0; j < 4; ++j) v[j] = ((const f32x4*)(T + (size_t)m * D))[64 * j + F.lane];
        ln_row_store(v, F.lane, a.in[I_LN1_G] + l * D, a.in[I_LN1_B] + l * D, a.out + (size_t)m * D, (bf16*)(F.ws + WS_X1B) + (size_t)m * D);
    }
}

constexpr int PH_PER_LAYER = 12, N_PHASES = 1 + DEPTH * PH_PER_LAYER;
__global__ void __launch_bounds__(NWAVES * 64, 2) mk_fwd(Args args) {
    extern __shared__ __attribute__((aligned(16))) unsigned char lds[];
    Frame F;
    F.lds = (LAS unsigned char*)lds; F.ws = args.ws; F.ctl = (gu32*)(args.ws + WS_CTL);
    F.tid = threadIdx.x; F.lane = F.tid & 63; F.wave = __builtin_amdgcn_readfirstlane(F.tid >> 6); F.G = gridDim.x; F.bid = blockIdx.x;
    volatile LAS unsigned* MISC = (volatile LAS unsigned*)(F.lds + MISC_OFF);
    for (int u = F.tid; u < (LDS_BYTES - LDSCTL_OFF) / 4; u += NWAVES * 64) ((LAS unsigned*)(F.lds + LDSCTL_OFF))[u] = 0u;
    __syncthreads();
    XcdBarrier bar; bar.bar = (unsigned*)(F.ctl + CW_BAR); bar.x = 0; bar.st = nullptr;
    if (!MK_PER_PHASE) bar = xcd_barrier_post((unsigned*)(F.ctl + CW_BAR), MISC + 8);
    const int lo = args.ph_lo, hi = args.ph_hi;
    unsigned char* ws = args.ws;
#ifndef PMASK
#define PMASK 0x1fff
#endif
#define IN(k) (lo <= (k) && (k) < hi)
#define EN(j) ((PMASK >> (j)) & 1)
#define LAUNDER() do { int t_ = threadIdx.x; asm volatile("" : "+v"(t_)); F.tid = t_; F.lane = t_ & 63; F.wave = __builtin_amdgcn_readfirstlane(t_ >> 6); \
        unsigned char* w_ = args.ws; asm volatile("" : "+s"(w_)); ws = w_; F.ws = w_; F.ctl = (gu32*)(w_ + WS_CTL); } while (0)
#ifdef NOKV
#define defined_NOKV 1
#else
#define defined_NOKV 0
#endif
#define SEAM(k) do { if (IN((k) + 1)) xcd_barrier(bar); } while (0)

    if (EN(0) && IN(0)) { LAUNDER(); ph_prologue(F, args); SEAM(0); }

#pragma unroll 1
    for (int l = 0; l < DEPTH; ++l) {
        const int p0 = 1 + l * PH_PER_LAYER;
        if (EN(1) && IN(p0 + 0)) { LAUNDER();
            if (!defined_NOKV && l == 0) { SchedKV S{(const char*)(ws + WS_MEMN), (const char*)(ws + WS_WKVT), F.G, F.bid}; EpiKV E{(bf16*)(ws + WS_KV)};
                pg8::gemm_phase<EpiKV, SchedKV, true>(F.lds, S, E); }
            SchedDense S; S.init(ws + WS_XB, ws + WS_WINT, D, M, NZ1, F.G, F.bid);
            EpiInProj E{(bf16*)(ws + WS_O), (bf16*)(ws + WS_V), (bf16*)(ws + WS_XBR), args.in[I_B_IN] + (size_t)l * INW};
            pg8::gemm_phase<EpiInProj, SchedDense, true>(F.lds, S, E);
            SEAM(p0 + 0);
        }
        if (EN(2) && IN(p0 + 1)) { LAUNDER();
            for (int it = F.bid; it < 1280 + 1024 + 1024; it += F.G) {
                if (it < 1280) item_lru(F, args, l, it, 1);
                else if (it < 2304) item_spatial(F, args, l, it - 1280);
                else { item_attn(F, l, it - 2304); }
                __syncthreads();
            }
            SEAM(p0 + 1);
        }
        if (EN(3) && IN(p0 + 2)) { LAUNDER(); for (int it = F.bid; it < 1280; it += F.G) { item_lru(F, args, l, it, 2); __syncthreads(); } SEAM(p0 + 2); }
        if (EN(4) && IN(p0 + 3)) { LAUNDER();
            SchedDense S; S.init(ws + WS_XB, ws + WS_WINT + (size_t)NZ1 * D * 2, D, M, NMG, F.G, F.bid);
            EpiGate E{(bf16*)(ws + WS_GA), args.in[I_B_IN] + (size_t)l * INW + NZ1};
            pg8::gemm_phase<EpiGate, SchedDense, true>(F.lds, S, E);
            SEAM(p0 + 3);
        }
        if (EN(5) && IN(p0 + 4)) { LAUNDER();
            SchedY S; S.init(ws, F.G, F.bid); EpiY E{(const bf16*)(ws + WS_GA), (const bf16*)(ws + WS_GBT), (const bf16*)(ws + WS_GC), (bf16*)(ws + WS_Y)};
            pg8::gemm_phase<EpiY, SchedY, false>(F.lds, S, E);
            SEAM(p0 + 4);
        }
        if (EN(6) && IN(p0 + 5)) { LAUNDER();
            const unsigned poison = (__hip_atomic_load(F.ctl + CW_TMO, RLX_AGENT) != 0u) || (F.G != 256);
            SchedDense S; S.init(ws + WS_Y, ws + WS_WOT, D, M, D, F.G, F.bid);
            pg8::PanelStats st{(unsigned*)(ws + WS_XCHG + (size_t)l * 524288), (unsigned*)(F.ctl + CW_SEAM + l * SEAM_BANK), (unsigned*)(F.ctl + CW_TMO), 4, LN_EPS, 0x700u + 0x40u * l};
            EpiLn E{args.out, (bf16*)(ws + WS_X1B), args.in[I_B_O] + l * D, args.in[I_LN1_G] + l * D, args.in[I_LN1_B] + l * D, st, poison};
            if (USE_FUSED_LN) { if (F.G == 256) pg8::gemm_phase<EpiLn, SchedDense, false>(F.lds, S, E); }
            else { EpiF32Res E2{args.out, (float*)(ws + WS_F2), args.in[I_B_O] + l * D}; pg8::gemm_phase<EpiF32Res, SchedDense, true>(F.lds, S, E2);
                 }
            SEAM(p0 + 5);
        }
        if (EN(7) && IN(p0 + 6)) { LAUNDER(); if (!USE_FUSED_LN) ph_ln1(F, args, l); SEAM(p0 + 6); }
        if (EN(8) && IN(p0 + 7)) { LAUNDER(); ph_router(F, args, l, nullptr); __syncthreads(); convert_layer_moe(F, args, l); SEAM(p0 + 7); }
        if (EN(9) && IN(p0 + 8)) { LAUNDER(); ph_gather(F, l); SEAM(p0 + 8); }
        if (EN(10) && IN(p0 + 9)) { LAUNDER();
            SchedMoE S{(const char*)(ws + WS_XG), D, (const char*)(ws + WS_WUPT), (size_t)512 * D * 2, 2, F.ctl + CW_MOE + l * 16 * 64, F.G, F.bid, D};
            EpiUp E{(const float*)(ws + WS_META) + 4 * NPAIR, (bf16*)(ws + WS_H)};
            pg8::gemm_phase<EpiUp, SchedMoE, true>(F.lds, S, E);
            SEAM(p0 + 9);
        }
        if (EN(11) && IN(p0 + 10)) { LAUNDER();
            SchedMoE S{(const char*)(ws + WS_H), DEXP, (const char*)(ws + WS_WDNT), (size_t)D * DEXP * 2, 4, F.ctl + CW_MOE + l * 16 * 64, F.G, F.bid, DEXP};
            EpiPlain E{(bf16*)(ws + WS_F2), D};
            pg8::gemm_phase<EpiPlain, SchedMoE, true>(F.lds, S, E);
            SEAM(p0 + 10);
        }
        if (EN(12) && IN(p0 + 11)) { LAUNDER(); ph_combine(F, args, l); if (l + 1 < DEPTH) { __syncthreads(); convert_layer_main(F, args, l + 1); } SEAM(p0 + 11); }
    }
#undef IN
#undef SEAM
}


#ifndef DBG_CHECKS
#define DBG_CHECKS 0
#endif
constexpr int CW_DBG = 60000;
__device__ __forceinline__ float dbg_dot(const bf16* a, const bf16* b, int K) { float s = 0.f; for (int k = 0; k < K; ++k) s += bf2f(a[k]) * bf2f(b[k]); return s; }
__device__ __forceinline__ float dbg_gelu(float x) { return 0.5f * x * (1.f + tanhf(0.7978845608f * (x + 0.044715f * x * x * x))); }
__device__ __forceinline__ void dbg_cmp(gu32* ctr, float e, float a) { if (!(fabsf(e - a) <= 0.03f + 0.02f * fabsf(e))) __hip_atomic_fetch_add(ctr, 1u, RLX_AGENT); }
__global__ void dbg_kernel(Args args, int which, int l) {
    unsigned char* ws = args.ws; gu32* ctr = (gu32*)(ws + WS_CTL) + CW_DBG + which;
    const long gid = (long)blockIdx.x * blockDim.x + threadIdx.x, gsz = (long)gridDim.x * blockDim.x;
    const bf16* XB = (const bf16*)(ws + WS_XB); const bf16* WINT = (const bf16*)(ws + WS_WINT); const bf16* O = (const bf16*)(ws + WS_O);
    const int NRS = 443;
    if (which == 1) {
        for (long i = gid; i < (long)NRS * NZ1; i += gsz) { const int r = (int)(i / NZ1) * 37, c = (int)(i % NZ1);
            const float z = dbg_dot(XB + (size_t)r * D, WINT + (size_t)c * D, D) + args.in[I_B_IN][(size_t)l * INW + c]; float e, a;
            if (c < 1024) { e = dbg_gelu(z); a = bf2f(O[(size_t)r * LDO + OC_U + c]); }
            else if (c < 2048) { e = dbg_gelu(z); a = bf2f(((const bf16*)(ws + WS_V))[(size_t)r * 1024 + c - 1024]); }
            else if (c < 3328) { e = z; a = bf2f(((const bf16*)(ws + WS_XBR))[(size_t)r * BW + c - 2048]); }
            else if (c < 4608) { e = dbg_gelu(z); a = bf2f(O[(size_t)r * LDO + OC_GB + c - 3328]); }
            else { e = z * 0.0625f; a = bf2f(O[(size_t)r * LDO + OC_Q + c - 4608]); }
            dbg_cmp(ctr, e, a); }
    } else if (which == 2) {
        for (long i = gid; i < (long)2 * 1024 * 2048; i += gsz) { const int ly = (int)(i / (1024 * 2048)), r = (int)((i / 2048) % 1024), c = (int)(i % 2048);
            const float e = dbg_dot((const bf16*)(ws + WS_MEMN) + (size_t)r * D, (const bf16*)(ws + WS_WKVT) + ((size_t)ly * 2048 + c) * D, D);
            dbg_cmp(ctr, e, bf2f(((const bf16*)(ws + WS_KV))[((size_t)ly * 1024 + r) * 2048 + c])); }
    } else if (which == 3) {
        for (long i = gid; i < (long)NRS * NMG; i += gsz) { const int r = (int)(i / NMG) * 37, c = (int)(i % NMG);
            const float z = dbg_dot(XB + (size_t)r * D, WINT + (size_t)(NZ1 + c) * D, D) + args.in[I_B_IN][(size_t)l * INW + NZ1 + c];
            { const float e_ = 1.f / (1.f + expf(-z)); const float a_ = bf2f(((const bf16*)(ws + WS_GA))[(size_t)(c >> 10) * ((size_t)M * 1024) + (size_t)r * 1024 + (c & 1023)]);
              if (!(fabsf(e_ - a_) <= 0.03f + 0.02f * fabsf(e_))) { __hip_atomic_fetch_add((gu32*)(ws + WS_CTL) + CW_DBG + 256 + (r >> 8), 1u, RLX_AGENT); __hip_atomic_fetch_add((gu32*)(ws + WS_CTL) + CW_DBG + 512 + (c >> 8), 1u, RLX_AGENT); __hip_atomic_fetch_add((gu32*)(ws + WS_CTL) + CW_DBG + 768 + (r & 255), 1u, RLX_AGENT); } }
              if (false) dbg_cmp(ctr, 0.f, bf2f(((const bf16*)(ws + WS_GA))[(size_t)(c >> 10) * ((size_t)M * 1024) + (size_t)r * 1024 + (c & 1023)])); }
    } else if (which == 4) {
        const bf16* PT = (const bf16*)(ws + WS_PT);
        for (long i = gid; i < (long)NRS * D; i += gsz) { const int r = (int)(i / D) * 37, c = (int)(i % D);
            const float ga = bf2f(((const bf16*)(ws + WS_GA))[(size_t)r * 1024 + c]), gb = bf2f(((const bf16*)(ws + WS_GBT))[(size_t)r * 1024 + c]), gc = bf2f(((const bf16*)(ws + WS_GC))[(size_t)r * 1024 + c]);
            const float e = ga * dbg_dot(O + (size_t)r * LDO + OC_U, PT + (size_t)c * LDO + OC_U, 1024) + gb * dbg_dot(O + (size_t)r * LDO + OC_GB, PT + (size_t)c * LDO + OC_GB, BW) + gc * dbg_dot(O + (size_t)r * LDO + OC_Q, PT + (size_t)c * LDO + OC_Q, 1024);
            dbg_cmp(ctr, e, bf2f(((const bf16*)(ws + WS_Y))[(size_t)r * 1024 + c])); }
    } else if (which == 5) {
        for (long i = gid; i < (long)NRS * D; i += gsz) { const int r = (int)(i / D) * 37, c = (int)(i % D);
            const float e = dbg_dot((const bf16*)(ws + WS_Y) + (size_t)r * D, (const bf16*)(ws + WS_WOT) + (size_t)c * D, D) + args.in[I_B_O][l * D + c] + ALPHA * args.out[(size_t)r * D + c];
            dbg_cmp(ctr, e, ((const float*)(ws + WS_F2))[(size_t)r * D + c]); }
    } else if (which >= 6 && which <= 8) {
        for (long i = gid; i < (long)NRS * 16; i += gsz) { const int r = (int)(i / 16) * 37, part = (int)(i % 16);
            const float* xr = args.in[I_X] + (size_t)r * D; float s1 = 0.f; for (int k = 0; k < D; ++k) s1 += xr[k]; const float mean = s1 / D; float s2 = 0.f; for (int k = 0; k < D; ++k) { const float d = xr[k] - mean; s2 += d * d; }
            const float rstd = 1.f / sqrtf(s2 / D + LN_EPS);
            for (int c = part * 64; c < part * 64 + 64; ++c) { const float e = (xr[c] - mean) * rstd * args.in[I_LN_IN_G][c] + args.in[I_LN_IN_B][c]; dbg_cmp(ctr, e, bf2f(XB[(size_t)r * D + c])); } }
    } else if (which == 100) {
        if (l == 77) { float c2 = 0.f; for (int k = 0; k < 3; ++k) if (__hip_atomic_load((gu32*)(ws + WS_CTL) + CW_DBG + 6 + k, RLX_AGENT) != 0u) c2 += 0.5f * (float)(1 << k); for (long i = gid; i < (long)M * D; i += gsz) args.out[i] += c2; return; }
        int npm = 0, npn = 0, nrr = 0; for (int k = 0; k < 64; ++k) npm += __hip_atomic_load((gu32*)(ws + WS_CTL) + CW_DBG + 256 + k, RLX_AGENT) != 0u; for (int k = 0; k < 12; ++k) npn += __hip_atomic_load((gu32*)(ws + WS_CTL) + CW_DBG + 512 + k, RLX_AGENT) != 0u;
        for (int k = 0; k < 256; ++k) nrr += __hip_atomic_load((gu32*)(ws + WS_CTL) + CW_DBG + 768 + k, RLX_AGENT) != 0u;
        int v = (l == 0) ? npm : (l == 1) ? npn : nrr; if (v > 38) v = 38; const float cst = 0.5f + 0.25f * (float)v;
        for (long i = gid; i < (long)M * D; i += gsz) args.out[i] += cst;
    }
}

extern "C" void kernel_launch(void* const* d_in, const int* in_sizes, int n_in, void* d_out, int out_size, void* d_ws, size_t ws_size, hipStream_t stream) {
    static int grid = 0;
    if (grid == 0) {
        if (n_in != 35 || in_sizes[0] != M * D || out_size != M * D || ws_size < WS_END) { fprintf(stderr, "kernel_launch: unexpected problem (n_in %d, in0 %d, out %d, ws %zu < %zu); nothing launched\n", n_in, n_in > 0 ? in_sizes[0] : -1, out_size, ws_size, (size_t)WS_END); grid = -1; return; }
        if (hipFuncSetAttribute((const void*)mk_fwd, hipFuncAttributeMaxDynamicSharedMemorySize, LDS_BYTES) != hipSuccess) { fprintf(stderr, "kernel_launch: hipFuncSetAttribute failed\n"); grid = -1; return; }
        int per_cu = 0;
        if (hipOccupancyMaxActiveBlocksPerMultiprocessor(&per_cu, (const void*)mk_fwd, NWAVES * 64, LDS_BYTES) != hipSuccess || per_cu < 1) fprintf(stderr, "kernel_launch: occupancy query reports %d workgroups per CU\n", per_cu);
        (void)hipGetLastError();
        grid = 256;
    }
    if (grid < 0) return;
    if (hipMemsetAsync((char*)d_ws + WS_CTL, 0, CTL_ZERO_BYTES, stream) != hipSuccess) { fprintf(stderr, "kernel_launch: hipMemsetAsync failed\n"); return; }
    Args a{};
    for (int i = 0; i < 35; ++i) a.in[i] = (const float*)d_in[i];
    a.out = (float*)d_out; a.ws = (unsigned char*)d_ws;
#if MK_PER_PHASE
    for (int p = 0; p < N_PHASES; ++p) { a.ph_lo = p; a.ph_hi = p + 1; hipLaunchKernelGGL(mk_fwd, dim3(grid), dim3(NWAVES * 64), LDS_BYTES, stream, a);
#if DBG_CHECKS
        const int l = (p - 1) / PH_PER_LAYER, k = (p - 1) % PH_PER_LAYER;
        if (p >= 1 && l == DBG_LAYER && DBG_CNT == 77) { if (k == 0) hipLaunchKernelGGL(dbg_kernel, dim3(2048), dim3(256), 0, stream, a, 6, l); if (k == 2) hipLaunchKernelGGL(dbg_kernel, dim3(2048), dim3(256), 0, stream, a, 7, l); if (k == 3) hipLaunchKernelGGL(dbg_kernel, dim3(2048), dim3(256), 0, stream, a, 8, l); }
        if (p >= 1 && l == DBG_LAYER) { const int which = (k == 0) ? 1 : (k == 3) ? 3 : (k == 4) ? 4 : (k == 5) ? 5 : 0;
            if (which && (which == DBG_W0 || which == DBG_W1 || which == DBG_W2)) hipLaunchKernelGGL(dbg_kernel, dim3(2048), dim3(256), 0, stream, a, which, l);
            if (k == 0 && l == 0 && (2 == DBG_W0 || 2 == DBG_W1 || 2 == DBG_W2)) hipLaunchKernelGGL(dbg_kernel, dim3(2048), dim3(256), 0, stream, a, 2, 0); }
#endif
    }
#if DBG_CHECKS
    hipLaunchKernelGGL(dbg_kernel, dim3(2048), dim3(256), 0, stream, a, 100, DBG_CNT);
#endif
#else
    a.ph_lo = 0; a.ph_hi = N_PHASES; hipLaunchKernelGGL(mk_fwd, dim3(grid), dim3(NWAVES * 64), LDS_BYTES, stream, a);
#endif
    const hipError_t le = hipPeekAtLastError();
    if (le != hipSuccess) fprintf(stderr, "kernel_launch: launch failed: %s\n", hipGetErrorName(le));
}
```

```cpp
#include <hip/hip_runtime.h>
#include <cstdio>
#include <cstdint>

#ifndef DBG_FSCALE
#define DBG_FSCALE 1.0f
#endif
#ifndef DBG_ZA
#define DBG_ZA 0
#endif
#ifndef DBG_ZB
#define DBG_ZB 0
#endif
#ifndef DBG_ZC
#define DBG_ZC 0
#endif
#ifndef USE_FUSED_LN
#define USE_FUSED_LN 0
#endif
#ifndef DBG_LAYER
#define DBG_LAYER 0
#define DBG_W0 0
#define DBG_W1 0
#define DBG_W2 0
#define DBG_CNT 0
#endif
#ifndef MK_PER_PHASE
#define MK_PER_PHASE 0
#endif

namespace pg8 {
#define PG8_LAS __attribute__((address_space(3)))
typedef unsigned short bf16_t;
typedef short bf16x8 __attribute__((ext_vector_type(8)));
typedef float f32x4 __attribute__((ext_vector_type(4)));
typedef float f32x2 __attribute__((ext_vector_type(2)));
typedef unsigned u32x4 __attribute__((ext_vector_type(4)));
typedef unsigned u32x2 __attribute__((ext_vector_type(2)));
constexpr int BM = 256, BK = 64, HALF = 128, HTB = HALF * BK * 2, STAGE_BYTES = 8 * HTB, NXCD = 8, WGM = 8;

__host__ __device__ __forceinline__ int lds_byte(int r, int c) { const int st = (r >> 4) * 2 + (c >> 5), rr = r & 15, cc = c & 31, ob = rr * 64 + cc * 2; return st * 1024 + (ob ^ (((ob >> 9) & 1) << 5)); }
__host__ __device__ __forceinline__ void stage_rc(int b, int& R, int& C) { const int st = b / 1024, sb = b % 1024, swz = sb ^ (((sb >> 9) & 1) << 5); R = (st >> 1) * 16 + swz / 64; C = (st & 1) * 32 + (swz % 64) / 2; }
__host__ __device__ __forceinline__ int perm32(int rho) { const int n = rho >> 4, i = rho & 15; return 8 * (i >> 2) + 4 * n + (i & 3); }

struct Unit { const char* A; const char* B; int K; int pm, pn, seg; };

typedef __bf16 bf16x2_t __attribute__((ext_vector_type(2)));
__device__ __forceinline__ unsigned cvt_pk_bf16(float lo, float hi) { f32x2 v = {lo, hi}; bf16x2_t b = __builtin_convertvector(v, bf16x2_t); return __builtin_bit_cast(unsigned, b); }
__device__ __forceinline__ float bf_lo(unsigned w) { return __uint_as_float(w << 16); }
__device__ __forceinline__ float bf_hi(unsigned w) { return __uint_as_float(w & 0xffff0000u); }
__device__ __forceinline__ float fast_sigmoid(float x) { return __builtin_amdgcn_rcpf(1.0f + __builtin_amdgcn_exp2f(-1.4426950408889634f * x)); }
__device__ __forceinline__ float gelu_tanh(float x) { const float u = x * (1.0f + 0.044715f * x * x); return x * __builtin_amdgcn_rcpf(1.0f + __builtin_amdgcn_exp2f(-2.302208198f * u)); }

template <int ACT  >
__device__ __forceinline__ void store_tile_bf16(const f32x4 (&acc)[2][2][4][2], bf16_t* tile, int ldc, const float* bias, float sc, int wr, int wc, int fr, int fq) {
    const int c0 = wc * 32 + 8 * fq;
    f32x4 bv[2][2];
#pragma unroll
    for (int bj = 0; bj < 2; ++bj)
#pragma unroll
        for (int n = 0; n < 2; ++n) bv[bj][n] = bias ? *(const f32x4*)(bias + c0 + bj * HALF + 4 * n) : (f32x4){0.f, 0.f, 0.f, 0.f};
#pragma unroll
    for (int ai = 0; ai < 2; ++ai)
#pragma unroll
        for (int m = 0; m < 4; ++m) { bf16_t* rowp = tile + (unsigned)((ai * HALF + wr * 64 + m * 16 + fr) * ldc + c0);
#pragma unroll
            for (int bj = 0; bj < 2; ++bj) { f32x4 v0 = acc[ai][bj][m][0] + bv[bj][0], v1 = acc[ai][bj][m][1] + bv[bj][1];
                if (ACT == 1) { for (int e = 0; e < 4; ++e) { v0[e] = gelu_tanh(v0[e]); v1[e] = gelu_tanh(v1[e]); } }
                if (ACT == 2) { for (int e = 0; e < 4; ++e) { v0[e] = fast_sigmoid(v0[e]); v1[e] = fast_sigmoid(v1[e]); } }
                v0 = v0 * sc; v1 = v1 * sc; u32x4 w; w.x = cvt_pk_bf16(v0[0], v0[1]); w.y = cvt_pk_bf16(v0[2], v0[3]); w.z = cvt_pk_bf16(v1[0], v1[1]); w.w = cvt_pk_bf16(v1[2], v1[3]);
                *(u32x4*)(rowp + bj * HALF) = w; } }
}

struct PanelStats {
    unsigned* xbuf;
    unsigned* cnt;
    unsigned* tmo;
    int ntn; float eps; unsigned code;
    __device__ __forceinline__ bool run(const f32x4 (&v)[2][2][4][2], const Unit& u, int wr, int wc, int fr, int fq, PG8_LAS unsigned char* lds, int wid, int lane) const {
        typedef float f32x2v __attribute__((ext_vector_type(2)));
        PG8_LAS f32x2v* P = (PG8_LAS f32x2v*)lds;
        PG8_LAS f32x2v* S = (PG8_LAS f32x2v*)(lds + 8192);
        PG8_LAS unsigned* flag = (PG8_LAS unsigned*)(lds + 8192 + 2048);
#pragma unroll
        for (int ai = 0; ai < 2; ++ai)
#pragma unroll
            for (int m = 0; m < 4; ++m) {
                float s = 0.f;
#pragma unroll
                for (int bj = 0; bj < 2; ++bj)
#pragma unroll
                    for (int n = 0; n < 2; ++n) { const f32x4 x = v[ai][bj][m][n]; s += (x[0] + x[1]) + (x[2] + x[3]); }
                s += __shfl_xor(s, 16); s += __shfl_xor(s, 32);
                const float mw = s * (1.0f / 64.0f); float q = 0.f;
#pragma unroll
                for (int bj = 0; bj < 2; ++bj)
#pragma unroll
                    for (int n = 0; n < 2; ++n) { const f32x4 d = v[ai][bj][m][n] - mw; q += (d[0] * d[0] + d[1] * d[1]) + (d[2] * d[2] + d[3] * d[3]); }
                q += __shfl_xor(q, 16); q += __shfl_xor(q, 32);
                if (fq == 0) P[(ai * HALF + wr * 64 + m * 16 + fr) * 4 + wc] = (f32x2v){mw, q};
            }
        asm volatile("s_waitcnt lgkmcnt(0)" ::: "memory"); __builtin_amdgcn_s_barrier(); asm volatile("" ::: "memory");
        const int row = wid * 32 + (lane & 31);
        if (lane < 32) {
            const f32x2v a = P[row * 4 + 0], b = P[row * 4 + 1], c = P[row * 4 + 2], d = P[row * 4 + 3];
            const float mt = (a.x + b.x + c.x + d.x) * 0.25f;
            const float da = a.x - mt, db = b.x - mt, dc = c.x - mt, dd = d.x - mt;
            const float m2 = (a.y + b.y) + (c.y + d.y) + 64.0f * ((da * da + db * db) + (dc * dc + dd * dd));
            unsigned long long* slot = (unsigned long long*)xbuf + ((size_t)(u.pm * BM + row) * 4 + u.pn);
            __hip_atomic_store(slot, ((unsigned long long)__float_as_uint(m2) << 32) | __float_as_uint(mt), __ATOMIC_RELAXED, __HIP_MEMORY_SCOPE_AGENT);
        }
        asm volatile("s_waitcnt vmcnt(0)" ::: "memory");
        if (lane == 0) __hip_atomic_fetch_add(cnt + 64 * u.pm, 1u, __ATOMIC_RELAXED, __HIP_MEMORY_SCOPE_AGENT);
        if (wid == 0) {
            bool dead = false; const unsigned long long t0 = __builtin_amdgcn_s_memrealtime(); const unsigned want = 8u * (unsigned)ntn;
            for (;;) {
                if ((unsigned)__builtin_amdgcn_readfirstlane(__hip_atomic_load(cnt + 64 * u.pm, __ATOMIC_RELAXED, __HIP_MEMORY_SCOPE_AGENT)) >= want) break;
                if (__builtin_amdgcn_s_memrealtime() - t0 > 2000000ull) {
                    if (lane == 0) { unsigned expect = 0u; __hip_atomic_compare_exchange_strong(tmo + 1, &expect, code | (unsigned)(u.pm & 0xff), __ATOMIC_RELAXED, __ATOMIC_RELAXED, __HIP_MEMORY_SCOPE_AGENT);
                                     __hip_atomic_store(tmo, 1u, __ATOMIC_RELAXED, __HIP_MEMORY_SCOPE_AGENT); }
                    dead = true; break; }
                __builtin_amdgcn_s_sleep(2);
            }
            __builtin_amdgcn_fence(__ATOMIC_ACQUIRE, "agent");
            if (lane == 0) flag[0] = dead ? 1u : 0u;
        }
        asm volatile("s_waitcnt vmcnt(0) lgkmcnt(0)" ::: "memory"); __builtin_amdgcn_s_barrier(); asm volatile("" ::: "memory");
        const bool bad = flag[0] != 0u;
        if (lane < 32) {
            const unsigned long long* slot = (const unsigned long long*)xbuf + (size_t)(u.pm * BM + row) * 4; float mt[4], m2[4]; float ms = 0.f;
#pragma unroll
            for (int t = 0; t < 4; ++t) { if (t < ntn) { const unsigned long long w = __hip_atomic_load(slot + t, __ATOMIC_RELAXED, __HIP_MEMORY_SCOPE_AGENT); mt[t] = __uint_as_float((unsigned)w); m2[t] = __uint_as_float((unsigned)(w >> 32)); } else { mt[t] = 0.f; m2[t] = 0.f; } ms += mt[t]; }
            const float mean = ms / (float)ntn; float q = 0.f;
#pragma unroll
            for (int t = 0; t < 4; ++t) if (t < ntn) { const float dm = mt[t] - mean; q += m2[t] + 256.0f * dm * dm; }
            S[row] = (f32x2v){mean, 1.0f / sqrtf(q / (256.0f * (float)ntn) + eps)};
        }
        asm volatile("s_waitcnt lgkmcnt(0)" ::: "memory"); __builtin_amdgcn_s_barrier(); asm volatile("" ::: "memory");
        return bad;
    }
};

template <class Epi, class Sched, bool ALIGN_EPI>
__device__ __forceinline__ void gemm_phase(PG8_LAS unsigned char* lds, const Sched& S, const Epi& E) {
    int tid_ = threadIdx.x; asm volatile("" : "+v"(tid_));
    const int tid = tid_, wid = __builtin_amdgcn_readfirstlane(tid >> 6), lane = tid & 63, wr = wid >> 2, wc = wid & 3, fr = lane & 15, fq = lane >> 4;
    const size_t kstep = (size_t)(BK * 2);
    const unsigned ldsw = (unsigned)wid * 1024u;
    const int aoff = lds_byte(wr * 64 + fr, fq * 8), boff = lds_byte(wc * 32 + fr, fq * 8);
#define PG8_VOFF(K_, vA_, vB_) do { _Pragma("unroll") for (int _i = 0; _i < 2; ++_i) { int R_, C_; stage_rc(tid * 16 + _i * 8192, R_, C_); const int Rb_ = Epi::PERM ? ((R_ & ~31) + perm32(R_ & 31)) : R_; \
        vA_[_i] = (unsigned)(R_ * (K_) + C_) * 2u; vB_[_i] = (unsigned)(Rb_ * (K_) + C_) * 2u; } } while (0)
#define PG8_SA(b, h) (((b) * 2 + (h)) * HTB)
#define PG8_SB(b, h) ((4 + (b) * 2 + (h)) * HTB)
#define PG8_STAGE(bufoff, gbase, voff) do { _Pragma("unroll") for (int _i = 0; _i < 2; ++_i) \
        __builtin_amdgcn_global_load_lds((const unsigned*)((const char*)(gbase) + (voff)[_i]), (PG8_LAS unsigned*)(lds + (bufoff) + ldsw + _i * 8192), 16, 0, 0); } while (0)
#define PG8_LDA(dst, b, h) do { _Pragma("unroll") for (int m = 0; m < 4; ++m) _Pragma("unroll") for (int k = 0; k < 2; ++k) dst[m][k] = *(const PG8_LAS bf16x8*)(lds + PG8_SA(b, h) + aoff + m * 2048 + k * 1024); } while (0)
#define PG8_LDB(dst, b, h) do { _Pragma("unroll") for (int n = 0; n < 2; ++n) _Pragma("unroll") for (int k = 0; k < 2; ++k) dst[n][k] = *(const PG8_LAS bf16x8*)(lds + PG8_SB(b, h) + boff + n * 2048 + k * 1024); } while (0)
#define PG8_MMA(ai, bj, At, Bt) do { __builtin_amdgcn_s_setprio(1); _Pragma("unroll") for (int m = 0; m < 4; ++m) _Pragma("unroll") for (int n = 0; n < 2; ++n) _Pragma("unroll") for (int k = 0; k < 2; ++k) \
        acc[ai][bj][m][n] = __builtin_amdgcn_mfma_f32_16x16x32_bf16(Bt[n][k], At[m][k], acc[ai][bj][m][n], 0, 0, 0); __builtin_amdgcn_s_setprio(0); } while (0)
#define PG8_WAIT_V(n) asm volatile("s_waitcnt vmcnt(" #n ")" ::: "memory")
#define PG8_WAIT_L(n) asm volatile("s_waitcnt lgkmcnt(" #n ")" ::: "memory")
#define PG8_BAR __builtin_amdgcn_s_barrier()
#define PG8_SCHED __builtin_amdgcn_sched_barrier(0)
    Unit cur, nxt; int ui = 0;
    if (!S.next(0, cur)) return;
    f32x4 acc[2][2][4][2];
#pragma unroll
    for (int a = 0; a < 2; ++a)
#pragma unroll
        for (int b = 0; b < 2; ++b)
#pragma unroll
            for (int m = 0; m < 4; ++m)
#pragma unroll
                for (int n = 0; n < 2; ++n) acc[a][b][m][n] = (f32x4){0.f, 0.f, 0.f, 0.f};
    bf16x8 At[4][2], B0[2][2], B1[2][2];
    unsigned vAc[2], vBc[2]; PG8_VOFF(S.ld, vAc, vBc);
    const char* cA = cur.A; const char* cB = cur.B; const size_t hsC = (size_t)HALF * S.ld * 2;
    S.a_ready(cur);
    PG8_STAGE(PG8_SB(0, 0), cB, vBc); PG8_STAGE(PG8_SB(0, 1), cB + hsC, vBc); PG8_STAGE(PG8_SA(0, 0), cA, vAc); PG8_STAGE(PG8_SA(0, 1), cA + hsC, vAc);
    if (wr == 1) PG8_BAR;
    PG8_WAIT_V(2); PG8_BAR;
    PG8_STAGE(PG8_SB(1, 0), cB + kstep, vBc); PG8_STAGE(PG8_SA(1, 0), cA + kstep, vAc); PG8_STAGE(PG8_SB(1, 1), cB + hsC + kstep, vBc);
    PG8_WAIT_V(6); PG8_BAR;
    for (;;) {
        const bool has_next = S.next(ui + 1, nxt);
        if (!has_next) nxt = cur;
        const char* nA = nxt.A; const char* nB = nxt.B;
        const int nt = cur.K / BK;
        for (int t = 0; t < nt; t += 2) {
            const bool last = (t == nt - 2);
            const char* a1 = cA + (size_t)(t + 1) * kstep;
            const char* a2 = last ? nA : cA + (size_t)(t + 2) * kstep; const char* b2 = last ? nB : cB + (size_t)(t + 2) * kstep;
            const char* a3 = a2 + kstep; const char* b3 = b2 + kstep;
            if (last && has_next) S.a_ready(nxt);
            PG8_LDB(B0, 0, 0); PG8_LDB(B1, 0, 1); PG8_SCHED; PG8_LDA(At, 0, 0); PG8_STAGE(PG8_SA(1, 1), a1 + hsC, vAc);
            PG8_WAIT_V(8); PG8_WAIT_L(0); PG8_BAR; PG8_MMA(0, 0, At, B0); PG8_MMA(0, 1, At, B1); PG8_BAR; PG8_SCHED;
            PG8_LDA(At, 0, 1); PG8_STAGE(PG8_SB(0, 0), b2, vBc); PG8_STAGE(PG8_SB(0, 1), b2 + hsC, vBc); PG8_STAGE(PG8_SA(0, 0), a2, vAc);
            PG8_WAIT_V(8); PG8_WAIT_L(0); PG8_BAR; PG8_MMA(1, 0, At, B0); PG8_MMA(1, 1, At, B1); PG8_BAR; PG8_SCHED;
            PG8_LDB(B0, 1, 0); PG8_LDB(B1, 1, 1); PG8_SCHED; PG8_LDA(At, 1, 0); PG8_STAGE(PG8_SA(0, 1), a2 + hsC, vAc);
            PG8_WAIT_V(8); PG8_WAIT_L(0); PG8_BAR; PG8_MMA(0, 0, At, B0); PG8_MMA(0, 1, At, B1); PG8_BAR; PG8_SCHED;
            PG8_LDA(At, 1, 1); PG8_STAGE(PG8_SB(1, 0), b3, vBc); PG8_STAGE(PG8_SB(1, 1), b3 + hsC, vBc); PG8_STAGE(PG8_SA(1, 0), a3, vAc);
            PG8_WAIT_V(8); PG8_WAIT_L(0); PG8_BAR; PG8_MMA(1, 0, At, B0); PG8_MMA(1, 1, At, B1); PG8_BAR; PG8_SCHED;
        }
        if constexpr (ALIGN_EPI) { if (wr == 0) PG8_BAR; }
        if constexpr (!Epi::AFTER_DRAIN) { int fr_ = fr, fq_ = fq; asm volatile("" : "+v"(fr_), "+v"(fq_));
            (void)E(acc, cur, wr, wc, fr_, fq_); S.done(cur); }
        if (!has_next) break;
        if constexpr (!Epi::KEEP) {
#pragma unroll
            for (int a = 0; a < 2; ++a)
#pragma unroll
                for (int b = 0; b < 2; ++b)
#pragma unroll
                    for (int m = 0; m < 4; ++m)
#pragma unroll
                        for (int n = 0; n < 2; ++n) acc[a][b][m][n] = (f32x4){0.f, 0.f, 0.f, 0.f};
        }
        cur = nxt; cA = nA; cB = nB; ++ui;
        if constexpr (ALIGN_EPI) { if (wr == 1) PG8_BAR; }
    }
    PG8_WAIT_V(0);
    if constexpr (!ALIGN_EPI) { if (wr == 0) PG8_BAR; }
    PG8_BAR;
    if constexpr (Epi::AFTER_DRAIN) { int fr_ = fr, fq_ = fq; asm volatile("" : "+v"(fr_), "+v"(fq_)); E.fused(acc, cur, wr, wc, fr_, fq_, lds, wid, lane); S.done(cur); }
#undef PG8_VOFF
#undef PG8_SA
#undef PG8_SB
#undef PG8_STAGE
#undef PG8_LDA
#undef PG8_LDB
#undef PG8_MMA
#undef PG8_WAIT_V
#undef PG8_WAIT_L
#undef PG8_BAR
#undef PG8_SCHED
}
}

constexpr int NB = 4, SEQ = 4096, D = 1024, M = NB * SEQ, NMEM = 256, DEPTH = 2;
constexpr int AW = 1024, BW = 1280, CW = 1024, INW = 8704, NZ1 = 5632  , NMG = 3072;
constexpr int NEXP = 16, DEXP = 256, NPAIR = 2 * M, MOE_ROWS = 36864  ;
constexpr float LN_EPS = 1e-5f, ALPHA = 1.4142135623730951f;

constexpr size_t MiB = 1u << 20;
constexpr size_t WS_CTL = 0, CTL_ZERO_BYTES = 1 * MiB;
constexpr size_t WS_XCHG = 1 * MiB;
constexpr size_t WS_SUMM = 2 * MiB;
constexpr size_t WS_META = WS_SUMM + 1310720;
constexpr size_t WS_SMALLW = 4 * MiB;
constexpr size_t WS_KV = 5 * MiB;
constexpr size_t WS_WINT = 13 * MiB;
constexpr size_t WS_PT = 30 * MiB;
constexpr size_t WS_WOT = WS_PT + 6815744;
constexpr size_t WS_XB = 39 * MiB;
constexpr int LDO = 3328;
constexpr size_t WS_O = 71 * MiB, WS_V = 175 * MiB, WS_XBR = 207 * MiB, WS_WMOE = 247 * MiB, WS_END = 271 * MiB;
constexpr int OC_U = 0, OC_GB = 1024, OC_Q = 2304;
constexpr size_t WS_GA = WS_V, WS_GBT = WS_V + 32 * MiB, WS_GC = WS_V + 64 * MiB;
constexpr size_t WS_Y = WS_XB, WS_X1B = WS_O, WS_XG = WS_V, WS_H = WS_XB, WS_F2 = WS_O + 32 * MiB;
constexpr size_t WS_MEMN = WS_WMOE, WS_WKVT = WS_WMOE + 2 * MiB;
constexpr size_t WS_WUPT = WS_WMOE, WS_WDNT = WS_WMOE + 16 * MiB;
static_assert(WS_WOT + 2 * MiB <= WS_XB && WS_META + 4 * 131072 + 147456 <= WS_SMALLW && WS_XG + (size_t)MOE_ROWS * 2048 <= WS_WMOE && WS_F2 + (size_t)MOE_ROWS * 2048 <= WS_V && WS_H + (size_t)MOE_ROWS * 512 <= WS_O && WS_O + (size_t)M * LDO * 2 <= WS_V, "d_ws map");
constexpr int CW_TMO = 0, CW_CODE = 1, CW_BAR = 4096, CW_SEAM = 16384, SEAM_BANK = 64 * 64, CW_MOE = 40960;
static_assert((CW_MOE + 2 * 16 * 64) * 4 <= (int)CTL_ZERO_BYTES, "ctl");

constexpr int RING_BYTES = 131072, LDSCTL_OFF = RING_BYTES, MISC_OFF = LDSCTL_OFF + 320, LDS_BYTES = 147456;
constexpr int NWAVES = 8;

#define GAS __attribute__((address_space(1)))
#define LAS __attribute__((address_space(3)))
typedef unsigned short bf16;
typedef unsigned v4u __attribute__((ext_vector_type(4)));
typedef unsigned v2u __attribute__((ext_vector_type(2)));
typedef float f32x4 __attribute__((ext_vector_type(4)));
typedef GAS unsigned gu32;
#define RLX_AGENT __ATOMIC_RELAXED, __HIP_MEMORY_SCOPE_AGENT
#define LDS_WAIT() asm volatile("s_waitcnt lgkmcnt(0)" ::: "memory")
#define VM_WAIT() asm volatile("s_waitcnt vmcnt(0)" ::: "memory")
__device__ __forceinline__ unsigned f2bf(float f) { unsigned u = __builtin_bit_cast(unsigned, f); return (u + 0x7fffu + ((u >> 16) & 1u)) >> 16; }
__device__ __forceinline__ unsigned pk2(float lo, float hi) { return f2bf(lo) | (f2bf(hi) << 16); }
__device__ __forceinline__ float bf2f(bf16 b) { return __uint_as_float((unsigned)b << 16); }
using pg8::bf_lo; using pg8::bf_hi;

#define XB_TMO      128
#define XB_XCNT(j)  (256  + 64 * (j))
#define XB_XSUB(j)  (1280 + 64 * (j))
#define XB_XGEN(j)  (2304 + 64 * (j))
#define XB_TOP      3328
#define XB_TOPGEN   3392
#define XCD_BAR_WORDS 3456
#define XB_SPIN_CAP (1u << 18)
__device__ __forceinline__ unsigned xb_ld(unsigned* p)              { return __hip_atomic_load(p, __ATOMIC_RELAXED, __HIP_MEMORY_SCOPE_AGENT); }
__device__ __forceinline__ unsigned xb_add(unsigned* p, unsigned v) { return __hip_atomic_fetch_add(p, v, __ATOMIC_RELAXED, __HIP_MEMORY_SCOPE_AGENT); }
__device__ __forceinline__ unsigned xb_xcc_id() { return (unsigned)__builtin_amdgcn_s_getreg((3 << 11) | 20) & 0xFu; }
#define XB_SPIN(cond, bar) do { unsigned _sp = 0; while (cond) { __builtin_amdgcn_s_sleep(1); \
    if ((++_sp & 255u) == 0u) { if (xb_ld(&(bar)[XB_TMO])) break; if (_sp > XB_SPIN_CAP) { atomicAdd(&(bar)[XB_TMO], 1u); break; } } } } while (0)
struct XcdBarrier { unsigned* bar; unsigned x; volatile LAS unsigned* st; };
__device__ __forceinline__ XcdBarrier xcd_barrier_post(unsigned* bar, volatile LAS unsigned* st) {
    XcdBarrier b; b.bar = bar; b.x = xb_xcc_id(); b.st = st;
    if (threadIdx.x == 0) (void)xb_add(&bar[XB_XCNT(b.x)], 1u);
    return b;
}
__device__ __forceinline__ void xcd_barrier_complete(unsigned* bar, unsigned x, unsigned& nloc, unsigned& nx) {
    const unsigned G = gridDim.x * gridDim.y * gridDim.z;
    unsigned sum, cnt, mine, sp = 0u;
    for (;;) {
        sum = 0u; cnt = 0u; mine = 0u;
#pragma unroll
        for (unsigned j = 0; j < 16; ++j) { const unsigned c = xb_ld(&bar[XB_XCNT(j)]); sum += c; cnt += (c > 0u) ? 1u : 0u; mine = (j == x) ? c : mine; }
        if (sum == G) break;
        __builtin_amdgcn_s_sleep(1);
        if ((++sp & 255u) == 0u) { if (xb_ld(&bar[XB_TMO])) break; if (sp > XB_SPIN_CAP) { atomicAdd(&bar[XB_TMO], 1u); break; } }
    }
    nloc = mine > 0u ? mine : 1u; nx = cnt > 0u ? cnt : 1u;
}
__device__ __forceinline__ void xcd_barrier(const XcdBarrier& b) {
    asm volatile("s_waitcnt vmcnt(0)" ::: "memory");
    __syncthreads();
    if (threadIdx.x == 0) {
        unsigned* bar = b.bar;
        __builtin_amdgcn_s_waitcnt(0);
        unsigned nloc = b.st[0], nx = b.st[1];
        if (nloc == 0u) { xcd_barrier_complete(bar, b.x, nloc, nx); b.st[0] = nloc; b.st[1] = nx; }
        const unsigned old = xb_add(&bar[XB_XSUB(b.x)], 1u);
        const unsigned gen = old / nloc;
        if (old + 1u == (gen + 1u) * nloc) {
            __builtin_amdgcn_fence(__ATOMIC_RELEASE, "agent");
            asm volatile("s_waitcnt vmcnt(0)" ::: "memory");
            const unsigned og = xb_add(&bar[XB_TOP], 1u);
            const unsigned tg = og / nx;
            if (og + 1u == (tg + 1u) * nx) xb_add(&bar[XB_TOPGEN], 1u);
            else XB_SPIN(xb_ld(&bar[XB_TOPGEN]) == tg, bar);
            __builtin_amdgcn_fence(__ATOMIC_ACQUIRE, "agent");
            xb_add(&bar[XB_XGEN(b.x)], 1u);
            asm volatile("s_waitcnt vmcnt(0)" ::: "memory");
        } else {
            XB_SPIN(xb_ld(&bar[XB_XGEN(b.x)]) == gen, bar);
            __builtin_amdgcn_fence(__ATOMIC_ACQUIRE, "agent");
            asm volatile("s_waitcnt vmcnt(0)" ::: "memory");
        }
    }
    __syncthreads();
}

struct Args { const float* in[35]; float* out; unsigned char* ws; int ph_lo, ph_hi; };
enum InIdx { I_X = 0, I_MEM, I_LN_IN_G, I_LN_IN_B, I_LN_MEM_G, I_LN_MEM_B, I_W_IN, I_B_IN, I_LN_V_G, I_LN_V_B, I_W_S, I_B_S, I_CONV_W, I_CONV_B, I_W_A, I_B_A, I_W_X, I_B_X, I_LAM,
             I_W_KV, I_P_A, I_P_B, I_P_C, I_W_O, I_B_O, I_LN1_G, I_LN1_B, I_W_RG, I_B_RG, I_W_RE, I_B_RE, I_W_UP, I_W_DOWN, I_LN2_G, I_LN2_B };
struct Frame {
    LAS unsigned char* lds; gu32* ctl; unsigned char* ws;
    int tid, lane, wave, G, bid;
};

__device__ __forceinline__ float wave_sum(float v) {
#pragma unroll
    for (int o = 1; o < 64; o <<= 1) v += __shfl_xor(v, o);
    return v;
}
__device__ __forceinline__ float wave_max(float v) {
#pragma unroll
    for (int o = 1; o < 64; o <<= 1) v = fmaxf(v, __shfl_xor(v, o));
    return v;
}

__device__ __forceinline__ void tr_item(const float* W, int K, int N, bf16* WT, int ldo, int mode, LAS float* scr, int item, int lane) {
    const int nblk = N / 32, kb = item / nblk, nb = item % nblk, k0 = 64 * kb, n0 = 32 * nb;
    int r0 = n0;
    if (mode == 1) { const int nn = n0 & 255; r0 = (nn >> 7) * 256 + (n0 >> 8) * 128 + (nn & 127); }
#pragma unroll 8
    for (int i = 0; i < 32; ++i) { const int kk = 2 * i + (lane >> 5); scr[kk * 33 + (lane & 31)] = W[(size_t)(k0 + kk) * N + n0 + (lane & 31)]; }
    LDS_WAIT(); asm volatile("" ::: "memory");
    const int c = lane & 7;
#pragma unroll
    for (int j = 0; j < 4; ++j) { const int n = (lane >> 3) + 8 * j; const LAS float* s = scr + (8 * c) * 33 + n;
        v4u o; o.x = pk2(s[0 * 33], s[1 * 33]); o.y = pk2(s[2 * 33], s[3 * 33]); o.z = pk2(s[4 * 33], s[5 * 33]); o.w = pk2(s[6 * 33], s[7 * 33]);
        *(GAS v4u*)(WT + (size_t)(r0 + n) * ldo + k0 + 8 * c) = o; }
    LDS_WAIT(); asm volatile("" ::: "memory");
}
__device__ __forceinline__ void tr_job(const Frame& F, LAS float* scr, const float* W, int K, int N, bf16* WT, int ldo, int mode, int& it_base) {
    const int NGW = F.G * NWAVES, gw = F.bid * NWAVES + F.wave;
    const int n = (K / 64) * (N / 32);
    int first = (gw - (it_base % NGW) + NGW) % NGW;
    for (int idx = first; idx < n; idx += NGW) tr_item(W, K, N, WT, ldo, mode, scr, idx, F.lane);
    it_base += n;
}
__device__ __forceinline__ void convert_layer_main(const Frame& F, const Args& a, int l) {
    LAS float* scr = (LAS float*)(F.lds + F.wave * 16384);
    int base = 0;
    tr_job(F, scr, a.in[I_W_IN] + (size_t)l * D * INW, D, INW, (bf16*)(F.ws + WS_WINT), D, 0, base);
    tr_job(F, scr, a.in[I_P_A] + (size_t)l * AW * D, AW, D, (bf16*)(F.ws + WS_PT) + OC_U, LDO, 0, base);
    tr_job(F, scr, a.in[I_P_B] + (size_t)l * BW * D, BW, D, (bf16*)(F.ws + WS_PT) + OC_GB, LDO, 0, base);
    tr_job(F, scr, a.in[I_P_C] + (size_t)l * CW * D, CW, D, (bf16*)(F.ws + WS_PT) + OC_Q, LDO, 0, base);
    tr_job(F, scr, a.in[I_W_O] + (size_t)l * D * D, D, D, (bf16*)(F.ws + WS_WOT), D, 0, base);
}
__device__ __forceinline__ void convert_layer_moe(const Frame& F, const Args& a, int l) {
    LAS float* scr = (LAS float*)(F.lds + F.wave * 16384);
    int base = 0;
    for (int e = 0; e < NEXP; ++e) tr_job(F, scr, a.in[I_W_UP] + (size_t)(l * NEXP + e) * D * 512, D, 512, (bf16*)(F.ws + WS_WUPT) + (size_t)e * 512 * D, D, 1, base);
    for (int e = 0; e < NEXP; ++e) tr_job(F, scr, a.in[I_W_DOWN] + (size_t)(l * NEXP + e) * DEXP * D, DEXP, D, (bf16*)(F.ws + WS_WDNT) + (size_t)e * D * DEXP, DEXP, 0, base);
}
__device__ __forceinline__ void ln_row_store(f32x4 (&v)[4], int lane, const float* g, const float* b, float* o32, bf16* o16) {
    float s = 0.f;
#pragma unroll
    for (int j = 0; j < 4; ++j) s += (v[j].x + v[j].y) + (v[j].z + v[j].w);
    const float mean = wave_sum(s) * (1.f / 1024.f); float s2 = 0.f;
#pragma unroll
    for (int j = 0; j < 4; ++j) { v[j] = v[j] - mean; s2 += (v[j].x * v[j].x + v[j].y * v[j].y) + (v[j].z * v[j].z + v[j].w * v[j].w); }
    const float rstd = 1.f / sqrtf(wave_sum(s2) * (1.f / 1024.f) + LN_EPS);
#pragma unroll
    for (int j = 0; j < 4; ++j) { const f32x4 gv = ((const f32x4*)g)[64 * j + lane], bv = ((const f32x4*)b)[64 * j + lane]; const f32x4 o = v[j] * rstd * gv + bv;
        if (o32) ((f32x4*)o32)[64 * j + lane] = o;
        if (o16) ((v2u*)o16)[64 * j + lane] = (v2u){pk2(o.x, o.y), pk2(o.z, o.w)}; }
}

struct SchedDense {
    const char* A; const char* Bt; int K, ld, nM, nN, nwg, G, c;
    __device__ void init(const void* A_, const void* Bt_, int K_, int M_, int N_, int G_, int c_) { A = (const char*)A_; Bt = (const char*)Bt_; K = K_; ld = K_; nM = M_ / 256; nN = N_ / 256; nwg = nM * nN; G = G_; c = c_; }
    __device__ __forceinline__ bool next(int i, pg8::Unit& u) const {
        const long L = (long)i * G + c; if (L >= nwg) return false;
        int wgid = (int)L; { const int q = nwg / 8, r = nwg % 8, xcd = wgid % 8, off = wgid / 8; wgid = (xcd < r ? xcd * (q + 1) : r * (q + 1) + (xcd - r) * q) + off; }
        const int nig = 8 * nN, gid = wgid / nig, fm = gid * 8, gsz = (nM - fm) < 8 ? (nM - fm) : 8;
        u.pm = fm + ((wgid % nig) % gsz); u.pn = (wgid % nig) / gsz; u.K = K; u.seg = 0;
        u.A = A + (size_t)u.pm * 256 * K * 2; u.B = Bt + (size_t)u.pn * 256 * K * 2; return true;
    }
    __device__ __forceinline__ void a_ready(const pg8::Unit&) const {}
    __device__ __forceinline__ void done(const pg8::Unit&) const {}
};
struct SchedKV {
    const char* A; const char* Bt; int G, c; static constexpr int ld = D;
    __device__ __forceinline__ bool next(int i, pg8::Unit& u) const {
        const int L = i * G + (G - 1 - c); if (L >= 64) return false;
        u.seg = L >> 5; u.pm = (L & 31) & 3; u.pn = (L & 31) >> 2; u.K = D;
        u.A = A + (size_t)u.pm * 256 * D * 2; u.B = Bt + ((size_t)u.seg * 2048 + (size_t)u.pn * 256) * D * 2; return true;
    }
    __device__ __forceinline__ void a_ready(const pg8::Unit&) const {}
    __device__ __forceinline__ void done(const pg8::Unit&) const {}
};
struct SchedY {
    const char *A, *B; int pm, pn; bool ok; static constexpr int ld = LDO;
    __device__ void init(const unsigned char* ws, int G, int c) { SchedDense s; s.init(nullptr, nullptr, D, M, D, G, c); pg8::Unit u; ok = s.next(0, u) && G == 256; pm = u.pm; pn = u.pn;
        A = (const char*)(ws + WS_O) + (size_t)pm * 256 * LDO * 2; B = (const char*)(ws + WS_PT) + (size_t)pn * 256 * LDO * 2; }
    __device__ __forceinline__ bool next(int i, pg8::Unit& u) const {
        if (!ok || i >= 3) return false;
        const int k0 = (i == 0) ? OC_U : (i == 1) ? OC_GB : OC_Q;
        u.pm = pm; u.pn = pn; u.seg = i; u.K = (i == 1) ? BW : 1024; u.A = A + k0 * 2; u.B = B + k0 * 2; return true;
    }
    __device__ __forceinline__ void a_ready(const pg8::Unit&) const {}
    __device__ __forceinline__ void done(const pg8::Unit&) const {}
};
struct SchedMoE {
    const char* A; int K; const char* W; size_t wstride; int ncol; gu32* cnt; int G, c; int ld;
    __device__ __forceinline__ bool next(int i, pg8::Unit& u) const {
        const int L = i * G + c, rt = L / ncol, pn = L % ncol;
        int acc = 0, e = -1;
#pragma unroll 1
        for (int k = 0; k < NEXP; ++k) { const int n = (int)((__hip_atomic_load(cnt + 64 * k, RLX_AGENT) + 255u) >> 8); if (e < 0 && rt < acc + n) e = k; acc += n; }
        e = __builtin_amdgcn_readfirstlane(e);
        if (e < 0) return false;
        u.pm = rt; u.pn = pn; u.seg = e; u.K = K;
        u.A = A + (size_t)rt * 256 * K * 2; u.B = W + (size_t)e * wstride + (size_t)pn * 256 * K * 2; return true;
    }
    __device__ __forceinline__ void a_ready(const pg8::Unit&) const {}
    __device__ __forceinline__ void done(const pg8::Unit&) const {}
};

using pg8::f32x2; using pg8::u32x4; using pg8::u32x2; using pg8::Unit; using pg8::HALF;
struct EpiInProj {
    static constexpr bool PERM = true, AFTER_DRAIN = false, KEEP = false;
    bf16 *O_, *V, *XBR; const float* bias;
    __device__ __forceinline__ bool operator()(f32x4 (&acc)[2][2][4][2], const Unit& u, int wr, int wc, int fr, int fq) const {
        const int t = u.pn; bf16* O; int ldc, ct, act; float sc = 1.f;
        if (t < 4) { O = O_ + OC_U; ldc = LDO; ct = t; act = 1; }
        else if (t < 8) { O = V; ldc = 1024; ct = t - 4; act = 1; }
        else if (t < 13) { O = XBR; ldc = BW; ct = t - 8; act = 0; }
        else if (t < 18) { O = O_ + OC_GB; ldc = LDO; ct = t - 13; act = 1; }
        else { O = O_ + OC_Q; ldc = LDO; ct = t - 18; act = 0; sc = 0.0625f; }
        bf16* tile = O + (size_t)u.pm * 256 * ldc + ct * 256; const float* b = bias + t * 256;
        if (act == 1) pg8::store_tile_bf16<1>(acc, tile, ldc, b, sc, wr, wc, fr, fq); else pg8::store_tile_bf16<0>(acc, tile, ldc, b, sc, wr, wc, fr, fq);
        return false;
    }
};
struct EpiGate {
    static constexpr bool PERM = true, AFTER_DRAIN = false, KEEP = false;
    bf16* G0; const float* bias;
    __device__ __forceinline__ bool operator()(f32x4 (&acc)[2][2][4][2], const Unit& u, int wr, int wc, int fr, int fq) const {
        const int t = u.pn; bf16* tile = G0 + (size_t)(t >> 2) * ((size_t)M * 1024) + (size_t)u.pm * 256 * 1024 + (t & 3) * 256;
        pg8::store_tile_bf16<2>(acc, tile, 1024, bias + t * 256, 1.f, wr, wc, fr, fq); return false;
    }
};
struct EpiKV {
    static constexpr bool PERM = true, AFTER_DRAIN = false, KEEP = false;
    bf16* KV;
    __device__ __forceinline__ bool operator()(f32x4 (&acc)[2][2][4][2], const Unit& u, int wr, int wc, int fr, int fq) const {
        bf16* tile = KV + ((size_t)u.seg * 1024 + (size_t)u.pm * 256) * 2048 + u.pn * 256;
        pg8::store_tile_bf16<0>(acc, tile, 2048, nullptr, 1.f, wr, wc, fr, fq); return false;
    }
};
struct EpiPlain {
    static constexpr bool PERM = true, AFTER_DRAIN = false, KEEP = false;
    bf16* O; int ldc;
    __device__ __forceinline__ bool operator()(f32x4 (&acc)[2][2][4][2], const Unit& u, int wr, int wc, int fr, int fq) const {
        pg8::store_tile_bf16<0>(acc, O + (size_t)u.pm * 256 * ldc + u.pn * 256, ldc, nullptr, 1.f, wr, wc, fr, fq); return false;
    }
};
struct EpiY {
    static constexpr bool PERM = true, AFTER_DRAIN = false, KEEP = true;
    const bf16 *GA, *GB_, *GC; bf16* Y;
    __device__ __forceinline__ bool operator()(f32x4 (&acc)[2][2][4][2], const Unit& u, int wr, int wc, int fr, int fq) const {
        int pm_ = u.pm, pn_ = u.pn; asm volatile("" : "+s"(pm_), "+s"(pn_));
        const unsigned t0 = (unsigned)(pm_ * 256 * 1024 + pn_ * 256 + wc * 32 + 8 * fq);
        const bool fin = (u.seg == 2);
        const GAS bf16* num = (const GAS bf16*)((u.seg == 0) ? GA : (u.seg == 1) ? GB_ : GC); const GAS bf16* den = (const GAS bf16*)((u.seg == 0) ? GB_ : GC);
#pragma unroll
        for (int ai = 0; ai < 2; ++ai)
#pragma unroll
            for (int m = 0; m < 4; ++m) { const unsigned ro = t0 + (unsigned)(ai * HALF + wr * 64 + m * 16 + fr) * 1024u;
#pragma unroll
                for (int bj = 0; bj < 2; ++bj) {
                    const u32x4 nw = *(const GAS u32x4*)(num + ro + bj * HALF); const u32x4 dw = *(const GAS u32x4*)(den + ro + bj * HALF);
#define EPIY_F(nv, dv) ((nv) * (fin ? 1.0f : __builtin_amdgcn_rcpf(fmaxf((dv), 1e-6f))))
                    acc[ai][bj][m][0][0] *= EPIY_F(bf_lo(nw.x), bf_lo(dw.x)); acc[ai][bj][m][0][1] *= EPIY_F(bf_hi(nw.x), bf_hi(dw.x));
                    acc[ai][bj][m][0][2] *= EPIY_F(bf_lo(nw.y), bf_lo(dw.y)); acc[ai][bj][m][0][3] *= EPIY_F(bf_hi(nw.y), bf_hi(dw.y));
                    acc[ai][bj][m][1][0] *= EPIY_F(bf_lo(nw.z), bf_lo(dw.z)); acc[ai][bj][m][1][1] *= EPIY_F(bf_hi(nw.z), bf_hi(dw.z));
                    acc[ai][bj][m][1][2] *= EPIY_F(bf_lo(nw.w), bf_lo(dw.w)); acc[ai][bj][m][1][3] *= EPIY_F(bf_hi(nw.w), bf_hi(dw.w));
#undef EPIY_F
                }
                asm volatile("" ::: "memory"); }
        if (fin) {
            GAS bf16* Yg = (GAS bf16*)Y;
#pragma unroll
            for (int ai = 0; ai < 2; ++ai)
#pragma unroll
                for (int m = 0; m < 4; ++m) { const unsigned ro = t0 + (unsigned)(ai * HALF + wr * 64 + m * 16 + fr) * 1024u;
#pragma unroll
                    for (int bj = 0; bj < 2; ++bj) { const f32x4 v0 = acc[ai][bj][m][0], v1 = acc[ai][bj][m][1];
                        u32x4 w; w.x = pg8::cvt_pk_bf16(v0[0], v0[1]); w.y = pg8::cvt_pk_bf16(v0[2], v0[3]); w.z = pg8::cvt_pk_bf16(v1[0], v1[1]); w.w = pg8::cvt_pk_bf16(v1[2], v1[3]);
                        *(GAS u32x4*)(Yg + ro + bj * HALF) = w; } }
        }
        return !fin;
    }
};
struct EpiLn {
    static constexpr bool PERM = false, AFTER_DRAIN = true, KEEP = false;
    float* X; bf16* XBo; const float *bias, *g, *b; pg8::PanelStats st; unsigned poison;
    __device__ __forceinline__ void fused(f32x4 (&acc)[2][2][4][2], const Unit& u, int wr, int wc, int fr, int fq, PG8_LAS unsigned char* lds, int wid, int lane) const {
        typedef float f32x2v __attribute__((ext_vector_type(2)));
        const PG8_LAS f32x2v* S = (const PG8_LAS f32x2v*)(lds + 8192);
        const int col0 = u.pn * 256 + wc * 32 + 4 * fq;
#pragma unroll
        for (int ai = 0; ai < 2; ++ai)
#pragma unroll
            for (int m = 0; m < 4; ++m) { const unsigned off = (unsigned)(u.pm * 256 + ai * HALF + wr * 64 + m * 16 + fr) * 1024u + col0;
#pragma unroll
                for (int bj = 0; bj < 2; ++bj)
#pragma unroll
                    for (int n = 0; n < 2; ++n) { const f32x4 xs = *(const f32x4*)(X + off + bj * HALF + n * 16); const f32x4 bv = *(const f32x4*)(bias + col0 + bj * HALF + n * 16);
                        acc[ai][bj][m][n] = acc[ai][bj][m][n] + bv + xs * ALPHA; }
                asm volatile("" : "+v"(acc[ai][0][m][0]), "+v"(acc[ai][0][m][1]), "+v"(acc[ai][1][m][0]), "+v"(acc[ai][1][m][1]));
                if (m & 1) asm volatile("" ::: "memory"); }
        const bool bad = st.run(acc, u, wr, wc, fr, fq, lds, wid, lane) || poison != 0u;
        const float qnan = __builtin_nanf("");
#pragma unroll
        for (int bj = 0; bj < 2; ++bj)
#pragma unroll
            for (int n = 0; n < 2; ++n) { const f32x4 gv = *(const f32x4*)(g + col0 + bj * HALF + n * 16), bb = *(const f32x4*)(b + col0 + bj * HALF + n * 16);
#pragma unroll
                for (int ai = 0; ai < 2; ++ai)
#pragma unroll
                    for (int m = 0; m < 4; ++m) { const int r = ai * HALF + wr * 64 + m * 16 + fr; const f32x2v sr = S[r]; const unsigned off = (unsigned)(u.pm * 256 + r) * 1024u + col0 + bj * HALF + n * 16;
                        f32x4 o = (acc[ai][bj][m][n] - sr.x) * sr.y * gv + bb; if (bad) o = (f32x4){qnan, qnan, qnan, qnan};
                        *(f32x4*)(X + off) = o; *(u32x2*)(XBo + off) = (u32x2){pg8::cvt_pk_bf16(o[0], o[1]), pg8::cvt_pk_bf16(o[2], o[3])}; } }
    }
};
struct EpiF32Res {
    static constexpr bool PERM = false, AFTER_DRAIN = false, KEEP = false;
    const float* X; float* T; const float* bias;
    __device__ __forceinline__ bool operator()(f32x4 (&acc)[2][2][4][2], const Unit& u, int wr, int wc, int fr, int fq) const {
        const int col0 = u.pn * 256 + wc * 32 + 4 * fq;
#pragma unroll
        for (int ai = 0; ai < 2; ++ai)
#pragma unroll
            for (int m = 0; m < 4; ++m) { const unsigned off = (unsigned)(u.pm * 256 + ai * HALF + wr * 64 + m * 16 + fr) * 1024u + col0;
#pragma unroll
                for (int bj = 0; bj < 2; ++bj)
#pragma unroll
                    for (int n = 0; n < 2; ++n) { const f32x4 xs = *(const f32x4*)(X + off + bj * HALF + n * 16); const f32x4 bv = *(const f32x4*)(bias + col0 + bj * HALF + n * 16);
                        *(f32x4*)(T + off + bj * HALF + n * 16) = acc[ai][bj][m][n] + bv + xs * ALPHA; }
                asm volatile("" ::: "memory"); }
        return false;
    }
};
struct EpiUp {
    static constexpr bool PERM = true, AFTER_DRAIN = false, KEEP = false;
    const float* ROWW; bf16* H;
    __device__ __forceinline__ bool operator()(f32x4 (&acc)[2][2][4][2], const Unit& u, int wr, int wc, int fr, int fq) const {
        const int c0 = u.pn * 128 + wc * 32 + 8 * fq;
#pragma unroll
        for (int ai = 0; ai < 2; ++ai)
#pragma unroll
            for (int m = 0; m < 4; ++m) { const unsigned row = (unsigned)(u.pm * 256 + ai * HALF + wr * 64 + m * 16 + fr); const float w = ROWW[row];
                float h[8];
#pragma unroll
                for (int n = 0; n < 2; ++n)
#pragma unroll
                    for (int e = 0; e < 4; ++e) { const float gv = acc[ai][0][m][n][e], uv = acc[ai][1][m][n][e]; h[n * 4 + e] = gv * pg8::fast_sigmoid(gv) * uv * w; }
                u32x4 o; o.x = pg8::cvt_pk_bf16(h[0], h[1]); o.y = pg8::cvt_pk_bf16(h[2], h[3]); o.z = pg8::cvt_pk_bf16(h[4], h[5]); o.w = pg8::cvt_pk_bf16(h[6], h[7]);
                *(u32x4*)(H + row * DEXP + c0) = o; }
        return false;
    }
};

__device__ __forceinline__ void unpack8(const v4u w, float* f) { f[0] = bf_lo(w.x); f[1] = bf_hi(w.x); f[2] = bf_lo(w.y); f[3] = bf_hi(w.y); f[4] = bf_lo(w.z); f[5] = bf_hi(w.z); f[6] = bf_lo(w.w); f[7] = bf_hi(w.w); }

__device__ __forceinline__ void ph_prologue(const Frame& F, const Args& a) {
    convert_layer_main(F, a, 0);
    { LAS float* scr = (LAS float*)(F.lds + F.wave * 16384); int base = 0;
      for (int l = 0; l < DEPTH; ++l) tr_job(F, scr, a.in[I_W_KV] + (size_t)l * D * 2048, D, 2048, (bf16*)(F.ws + WS_WKVT) + (size_t)l * 2048 * D, D, 0, base); }
    const int gw = F.bid * NWAVES + F.wave, NGW = F.G * NWAVES;
    for (int m = gw; m < M + NB * NMEM; m += NGW) {
        const bool is_x = m < M; const int r = is_x ? m : m - M;
        const float* src = (is_x ? a.in[I_X] : a.in[I_MEM]) + (size_t)r * D;
        f32x4 v[4];
#pragma unroll
        for (int j = 0; j < 4; ++j) v[j] = ((const f32x4*)src)[64 * j + F.lane];
        if (is_x) ln_row_store(v, F.lane, a.in[I_LN_IN_G], a.in[I_LN_IN_B], a.out + (size_t)r * D, (bf16*)(F.ws + WS_XB) + (size_t)r * D);
        else ln_row_store(v, F.lane, a.in[I_LN_MEM_G], a.in[I_LN_MEM_B], nullptr, (bf16*)(F.ws + WS_MEMN) + (size_t)r * D);
    }
}

__device__ __forceinline__ void item_spatial(const Frame& F, const Args& a, int l, int item) {
    const int g = item & 7, bc = item >> 3; const size_t row0 = (size_t)bc * 128;
    const bf16* V = (const bf16*)(F.ws + WS_V); bf16* U = (bf16*)(F.ws + WS_O) + OC_U;
    LAS float* stat = (LAS float*)F.lds;
    LAS float* vn = (LAS float*)(F.lds + 1024);
    for (int i = 0; i < 16; ++i) { const int t = F.wave * 16 + i; const bf16* vr = V + (row0 + t) * 1024;
        float x[16]; unpack8(*(const v4u*)(vr + F.lane * 8), x); unpack8(*(const v4u*)(vr + 512 + F.lane * 8), x + 8);
        float s = 0.f;
#pragma unroll
        for (int e = 0; e < 16; ++e) s += x[e];
        const float mean = wave_sum(s) * (1.f / 1024.f); float q = 0.f;
#pragma unroll
        for (int e = 0; e < 16; ++e) { const float d = x[e] - mean; q += d * d; }
        const float rstd = 1.f / sqrtf(wave_sum(q) * (1.f / 1024.f) + LN_EPS);
        if (F.lane == 0) { stat[2 * t] = mean; stat[2 * t + 1] = rstd; } }
    __syncthreads();
    { const int d = F.tid & 127; const float gg = a.in[I_LN_V_G][l * AW + g * 128 + d], bb = a.in[I_LN_V_B][l * AW + g * 128 + d];
      for (int i = 0; i < 32; ++i) { const int s = (F.tid >> 7) + 4 * i; const float v = bf2f(V[(row0 + s) * 1024 + g * 128 + d]); vn[s * 128 + d] = (v - stat[2 * s]) * stat[2 * s + 1] * gg + bb; } }
    __syncthreads();
    { const int d = F.tid & 127, tq = F.tid >> 7; const float* ws_ = a.in[I_W_S] + (size_t)(l * 8 + g) * 128 * 128; const float* bs_ = a.in[I_B_S] + (l * 8 + g) * 128;
      for (int t = tq * 32; t < tq * 32 + 32; ++t) { const float* wrow = ws_ + t * 128; float acc = 0.f;
          for (int s = 0; s <= t; ++s) acc += wrow[s] * vn[s * 128 + d];
          const size_t idx = (row0 + t) * LDO + g * 128 + d; U[idx] = DBG_ZA ? (bf16)0 : (bf16)f2bf(bf2f(U[idx]) * (acc + bs_[t])); } }
    __syncthreads();
}

__device__ __forceinline__ void item_attn(const Frame& F, int l, int item) {
    const int tile = item & 63, bh = item >> 6, h = bh & 3, b = bh >> 2, lane = F.lane;
    LAS float* qs = (LAS float*)F.lds + F.wave * 2048;
    LAS float* ps = qs + 1024;
    const bf16* Kb = (const bf16*)(F.ws + WS_KV) + ((size_t)l * 1024 + b * 256) * 2048 + h * 256; const bf16* Vb = Kb + 1024;
    bf16* Q = (bf16*)(F.ws + WS_O) + OC_Q;
    for (int tg = 0; tg < 2; ++tg) {
        const size_t row = (size_t)b * SEQ + tile * 64 + F.wave * 8 + tg * 4;
        { const int tk = lane >> 4, d0 = (lane & 15) * 16; const bf16* qp = Q + (row + tk) * LDO + h * 256 + d0; float x[16]; unpack8(*(const v4u*)qp, x); unpack8(*(const v4u*)(qp + 8), x + 8);
#pragma unroll
          for (int e = 0; e < 16; ++e) qs[tk * 256 + d0 + e] = x[e]; }
        LDS_WAIT(); asm volatile("" ::: "memory");
        float s[4][4];
#pragma unroll
        for (int tk = 0; tk < 4; ++tk)
#pragma unroll
            for (int j = 0; j < 4; ++j) s[tk][j] = 0.f;
        for (int d0 = 0; d0 < 256; d0 += 8) {
            float kv[4][8];
#pragma unroll
            for (int j = 0; j < 4; ++j) unpack8(*(const v4u*)(Kb + (size_t)(lane + 64 * j) * 2048 + d0), kv[j]);
#pragma unroll
            for (int tk = 0; tk < 4; ++tk) { const f32x4 q0 = *(const LAS f32x4*)(qs + tk * 256 + d0), q1 = *(const LAS f32x4*)(qs + tk * 256 + d0 + 4);
#pragma unroll
                for (int j = 0; j < 4; ++j) s[tk][j] += (q0[0] * kv[j][0] + q0[1] * kv[j][1]) + (q0[2] * kv[j][2] + q0[3] * kv[j][3]) + (q1[0] * kv[j][4] + q1[1] * kv[j][5]) + (q1[2] * kv[j][6] + q1[3] * kv[j][7]); }
        }
#pragma unroll
        for (int tk = 0; tk < 4; ++tk) { float mx = fmaxf(fmaxf(s[tk][0], s[tk][1]), fmaxf(s[tk][2], s[tk][3])); mx = wave_max(mx);
            float e[4], sum = 0.f;
#pragma unroll
            for (int j = 0; j < 4; ++j) { e[j] = __expf(s[tk][j] - mx); sum += e[j]; }
            sum = wave_sum(sum); const float inv = 1.f / sum;
#pragma unroll
            for (int j = 0; j < 4; ++j) ps[tk * 256 + lane + 64 * j] = e[j] * inv; }
        LDS_WAIT(); asm volatile("" ::: "memory");
        float o[4][4];
#pragma unroll
        for (int tk = 0; tk < 4; ++tk)
#pragma unroll
            for (int e = 0; e < 4; ++e) o[tk][e] = 0.f;
        for (int k = 0; k < 256; k += 4) {
            float v[4][4];
#pragma unroll
            for (int kk = 0; kk < 4; ++kk) { const v2u w = *(const v2u*)(Vb + (size_t)(k + kk) * 2048 + 4 * lane); v[kk][0] = bf_lo(w.x); v[kk][1] = bf_hi(w.x); v[kk][2] = bf_lo(w.y); v[kk][3] = bf_hi(w.y); }
#pragma unroll
            for (int tk = 0; tk < 4; ++tk) { const f32x4 p4 = *(const LAS f32x4*)(ps + tk * 256 + k);
#pragma unroll
                for (int kk = 0; kk < 4; ++kk)
#pragma unroll
                    for (int e = 0; e < 4; ++e) o[tk][e] += p4[kk] * v[kk][e]; }
        }
#pragma unroll
        for (int tk = 0; tk < 4; ++tk) *(v2u*)(Q + (row + tk) * LDO + h * 256 + 4 * lane) = DBG_ZC ? (v2u){0u, 0u} : (v2u){pk2(o[tk][0], o[tk][1]), pk2(o[tk][2], o[tk][3])};
        LDS_WAIT(); asm volatile("" ::: "memory");
    }
}

__device__ __forceinline__ void item_lru(const Frame& F, const Args& a, int l, int item, int pass) {
    const int h = item % 10, b = (item / 10) & 3, c = item / 40, ch = h * 128 + (F.tid & 127), j = F.tid & 127, tq = F.tid >> 7;
    LAS float* cx = (LAS float*)F.lds; LAS float* As = cx + 8192; LAS float* Bs = As + 8192;
    const float* wa = a.in[I_W_A] + (size_t)(l * 10 + h) * 128 * 128; const float* wx = a.in[I_W_X] + (size_t)(l * 10 + h) * 128 * 128;
    const float ba = a.in[I_B_A][l * BW + ch], bxb = a.in[I_B_X][l * BW + ch], sp = log1pf(expf(-a.in[I_LAM][l * BW + ch]));
    const float cw0 = a.in[I_CONV_W][(l * 4 + 0) * BW + ch], cw1 = a.in[I_CONV_W][(l * 4 + 1) * BW + ch], cw2 = a.in[I_CONV_W][(l * 4 + 2) * BW + ch], cw3 = a.in[I_CONV_W][(l * 4 + 3) * BW + ch], cb = a.in[I_CONV_B][l * BW + ch];
    const bf16* XBR = (const bf16*)(F.ws + WS_XBR) + (size_t)b * SEQ * BW + ch; bf16* GB = (bf16*)(F.ws + WS_O) + OC_GB + (size_t)b * SEQ * LDO + ch;
    float* SUMM = (float*)(F.ws + WS_SUMM);
    float hst = 0.f, P = 1.f;
    if (pass == 2 && tq == 0) for (int cc = 0; cc < c; ++cc) { const float a_ = SUMM[((size_t)(b * 32 + cc) * BW + ch) * 2], h_ = SUMM[((size_t)(b * 32 + cc) * BW + ch) * 2 + 1]; hst = a_ * hst + h_; }
    for (int half = 0; half < 2; ++half) {
        const int tbase = c * 128 + half * 64;
        for (int tt = 0; tt < 16; ++tt) { const int t = tq * 16 + tt, pos = tbase + t; float acc = cb;
            if (pos >= 3) acc += cw0 * bf2f(XBR[(size_t)(pos - 3) * BW]);
            if (pos >= 2) acc += cw1 * bf2f(XBR[(size_t)(pos - 2) * BW]);
            if (pos >= 1) acc += cw2 * bf2f(XBR[(size_t)(pos - 1) * BW]);
            acc += cw3 * bf2f(XBR[(size_t)pos * BW]);
            cx[t * 128 + j] = acc; }
        __syncthreads();
        float ra[16], rx[16];
#pragma unroll
        for (int tt = 0; tt < 16; ++tt) { ra[tt] = 0.f; rx[tt] = 0.f; }
        for (int i = 0; i < 128; ++i) { const float wai = wa[i * 128 + j], wxi = wx[i * 128 + j];
#pragma unroll
            for (int tt = 0; tt < 16; ++tt) { const float cv = cx[(tq * 16 + tt) * 128 + i]; ra[tt] += cv * wai; rx[tt] += cv * wxi; } }
#pragma unroll
        for (int tt = 0; tt < 16; ++tt) { const int t = tq * 16 + tt; const float r = 1.f / (1.f + expf(-(ra[tt] + ba))), ii = 1.f / (1.f + expf(-(rx[tt] + bxb)));
            const float la = -8.0f * r * sp, av = expf(la), mult = sqrtf(-expm1f(2.f * la)); As[t * 128 + j] = av; Bs[t * 128 + j] = mult * ii * cx[t * 128 + j]; }
        __syncthreads();
        if (tq == 0) for (int t = 0; t < 64; ++t) { const float av = As[t * 128 + j]; hst = av * hst + Bs[t * 128 + j]; P *= av;
            if (pass == 2) { const size_t idx = (size_t)(tbase + t) * LDO; GB[idx] = DBG_ZB ? (bf16)0 : (bf16)f2bf(hst * bf2f(GB[idx])); } }
        __syncthreads();
    }
    if (pass == 1 && tq == 0) { SUMM[((size_t)(b * 32 + c) * BW + ch) * 2] = P; SUMM[((size_t)(b * 32 + c) * BW + ch) * 2 + 1] = hst; }
}

__device__ __forceinline__ void ph_router(const Frame& F, const Args& a, int l, const bf16*  ) {
    LAS int* s_e = (LAS int*)F.lds; LAS float* s_w = (LAS float*)(F.lds + 512); LAS int* s_cnt = (LAS int*)(F.lds + 1024); LAS int* s_base = s_cnt + 16;
    const float* wrg = a.in[I_W_RG] + (size_t)l * D * 4; const float* wre = a.in[I_W_RE] + (size_t)l * D * 16; const float* brg = a.in[I_B_RG] + l * 4; const float* bre = a.in[I_B_RE] + l * 16;
    int* EID = (int*)(F.ws + WS_META); int* POS = EID + NPAIR; float* WGT = (float*)(POS + NPAIR);
    gu32* gcnt = F.ctl + CW_MOE + l * 16 * 64;
    for (int tb = F.bid; tb < M / 64; tb += F.G) {
        if (F.tid < 16) s_cnt[F.tid] = 0;
        for (int i = 0; i < 8; ++i) { const int tok = tb * 64 + F.wave * 8 + i; const float* xr = a.out + (size_t)tok * D;
            float lg[20];
#pragma unroll
            for (int o = 0; o < 20; ++o) lg[o] = 0.f;
#pragma unroll 2
            for (int i2 = 0; i2 < 16; ++i2) { const int d = 64 * i2 + F.lane; const float x = xr[d];
                const f32x4 g4 = *(const f32x4*)(wrg + d * 4);
#pragma unroll
                for (int o = 0; o < 4; ++o) lg[o] += x * g4[o];
#pragma unroll
                for (int q = 0; q < 4; ++q) { const f32x4 e4 = *(const f32x4*)(wre + d * 16 + 4 * q);
#pragma unroll
                    for (int o = 0; o < 4; ++o) lg[4 + 4 * q + o] += x * e4[o]; } }
#pragma unroll
            for (int o = 0; o < 20; ++o) lg[o] = wave_sum(lg[o]);
            if (F.lane == 0) {
                float gl[4]; int gt = 0;
#pragma unroll
                for (int o = 0; o < 4; ++o) gl[o] = lg[o] + brg[o];
                float gm = gl[0];
#pragma unroll
                for (int o = 1; o < 4; ++o) if (gl[o] > gm) { gm = gl[o]; gt = o; }
                float gs = 0.f;
#pragma unroll
                for (int o = 0; o < 4; ++o) gs += expf(gl[o] - gm);
                const float ptop = 1.f / gs;
                float el[4];
#pragma unroll
                for (int o = 0; o < 4; ++o) { float v = 0.f;
#pragma unroll
                    for (int q = 0; q < 4; ++q) v = (gt == q) ? lg[4 + 4 * q + o] + bre[4 * q + o] : v;
                    el[o] = v; }
                int i1 = 0;
#pragma unroll
                for (int o = 1; o < 4; ++o) if (el[o] > el[i1]) i1 = o;
                int i2 = (i1 == 0) ? 1 : 0;
#pragma unroll
                for (int o = 0; o < 4; ++o) if (o != i1 && o != i2 && el[o] > el[i2]) i2 = o;
                const float e1 = 1.f, e2 = expf(el[i2] - el[i1]); const float inv = ptop / (e1 + e2);
                const int p = (F.wave * 8 + i) * 2;
                s_e[p] = gt * 4 + i1; s_w[p] = e1 * inv; s_e[p + 1] = gt * 4 + i2; s_w[p + 1] = e2 * inv;
            } }
        __syncthreads();
        int mye = 0, mypos = 0;
        if (F.tid < 128) { mye = s_e[F.tid]; for (int q = 0; q < F.tid; ++q) mypos += (s_e[q] == mye) ? 1 : 0; atomicAdd((int*)&s_cnt[mye], 1); }
        __syncthreads();
        if (F.tid < 16) s_base[F.tid] = (int)__hip_atomic_fetch_add(gcnt + 64 * F.tid, (unsigned)s_cnt[F.tid], RLX_AGENT);
        __syncthreads();
        if (F.tid < 128) { const int p = tb * 128 + F.tid; EID[p] = mye; POS[p] = s_base[mye] + mypos; WGT[p] = s_w[F.tid]; }
        __syncthreads();
    }
}
__device__ __forceinline__ void ph_gather(const Frame& F, int l) {
    const int* EID = (const int*)(F.ws + WS_META); const int* POS = EID + NPAIR; const float* WGT = (const float*)(POS + NPAIR); int* ROWOF = (int*)(WGT + NPAIR); float* ROWW = (float*)(ROWOF + NPAIR);
    gu32* gcnt = F.ctl + CW_MOE + l * 16 * 64;
    const bf16* X1B = (const bf16*)(F.ws + WS_X1B); bf16* XG = (bf16*)(F.ws + WS_XG);
    const int gw = F.bid * NWAVES + F.wave, NGW = F.G * NWAVES;
    for (int p = gw; p < NPAIR; p += NGW) {
        const int e = EID[p]; int off = 0;
        for (int k = 0; k < NEXP; ++k) { const int n = (int)((__hip_atomic_load(gcnt + 64 * k, RLX_AGENT) + 255u) & ~255u); off += (k < e) ? n : 0; }
        const int row = off + POS[p];
        const v4u* src = (const v4u*)(X1B + (size_t)(p >> 1) * D); v4u* dst = (v4u*)(XG + (size_t)row * D);
        dst[F.lane] = src[F.lane]; dst[64 + F.lane] = src[64 + F.lane];
        if (F.lane == 0) { ROWOF[p] = row; ROWW[row] = WGT[p]; }
    }
}
__device__ __forceinline__ void ph_combine(const Frame& F, const Args& a, int l) {
    const int* ROWOF = (const int*)(F.ws + WS_META) + 3 * NPAIR; const bf16* F2 = (const bf16*)(F.ws + WS_F2);
    const int gw = F.bid * NWAVES + F.wave, NGW = F.G * NWAVES;
    for (int m = gw; m < M; m += NGW) {
        const int r0 = ROWOF[2 * m], r1 = ROWOF[2 * m + 1];
        f32x4 v[4];
#pragma unroll
        for (int j = 0; j < 4; ++j) { const f32x4 x = ((const f32x4*)(a.out + (size_t)m * D))[64 * j + F.lane];
            const v2u w0 = ((const v2u*)(F2 + (size_t)r0 * D))[64 * j + F.lane], w1 = ((const v2u*)(F2 + (size_t)r1 * D))[64 * j + F.lane];
            v[j] = x * ALPHA + ((f32x4){bf_lo(w0.x), bf_hi(w0.x), bf_lo(w0.y), bf_hi(w0.y)} + (f32x4){bf_lo(w1.x), bf_hi(w1.x), bf_lo(w1.y), bf_hi(w1.y)}) * DBG_FSCALE; }
        ln_row_store(v, F.lane, a.in[I_LN2_G] + l * D, a.in[I_LN2_B] + l * D, a.out + (size_t)m * D, (bf16*)(F.ws + WS_XB) + (size_t)m * D);
    }
}

__device__ __forceinline__ void ph_ln1(const Frame& F, const Args& a, int l) {
    const float* T = (const float*)(F.ws + WS_F2);
    const int gw = F.bid * NWAVES + F.wave, NGW = F.G * NWAVES;
    for (int m = gw; m < M; m += NGW) {
        f32x4 v[4];
#pragma unroll
        for (int j = 0; j < 4; ++j) v[j] = ((const f32x4*)(T + (size_t)m * D))[64 * j + F.lane];
        ln_row_store(v, F.lane, a.in[I_LN1_G] + l * D, a.in[I_LN1_B] + l * D, a.out + (size_t)m * D, (bf16*)(F.ws + WS_X1B) + (size_t)m * D);
    }
}

constexpr int PH_PER_LAYER = 12, N_PHASES = 1 + DEPTH * PH_PER_LAYER;
__global__ void __launch_bounds__(NWAVES * 64, 2) mk_fwd(Args args) {
    extern __shared__ __attribute__((aligned(16))) unsigned char lds[];
    Frame F;
    F.lds = (LAS unsigned char*)lds; F.ws = args.ws; F.ctl = (gu32*)(args.ws + WS_CTL);
    F.tid = threadIdx.x; F.lane = F.tid & 63; F.wave = __builtin_amdgcn_readfirstlane(F.tid >> 6); F.G = gridDim.x; F.bid = blockIdx.x;
    volatile LAS unsigned* MISC = (volatile LAS unsigned*)(F.lds + MISC_OFF);
    for (int u = F.tid; u < (LDS_BYTES - LDSCTL_OFF) / 4; u += NWAVES * 64) ((LAS unsigned*)(F.lds + LDSCTL_OFF))[u] = 0u;
    __syncthreads();
    XcdBarrier bar; bar.bar = (unsigned*)(F.ctl + CW_BAR); bar.x = 0; bar.st = nullptr;
    if (!MK_PER_PHASE) bar = xcd_barrier_post((unsigned*)(F.ctl + CW_BAR), MISC + 8);
    const int lo = args.ph_lo, hi = args.ph_hi;
    unsigned char* ws = args.ws;
#ifndef PMASK
#define PMASK 0x1fff
#endif
#define IN(k) (lo <= (k) && (k) < hi)
#define EN(j) ((PMASK >> (j)) & 1)
#define LAUNDER() do { int t_ = threadIdx.x; asm volatile("" : "+v"(t_)); F.tid = t_; F.lane = t_ & 63; F.wave = __builtin_amdgcn_readfirstlane(t_ >> 6); \
        unsigned char* w_ = args.ws; asm volatile("" : "+s"(w_)); ws = w_; F.ws = w_; F.ctl = (gu32*)(w_ + WS_CTL); } while (0)
#ifdef NOKV
#define defined_NOKV 1
#else
#define defined_NOKV 0
#endif
#define SEAM(k) do { if (IN((k) + 1)) xcd_barrier(bar); } while (0)

    if (EN(0) && IN(0)) { LAUNDER(); ph_prologue(F, args); SEAM(0); }

#pragma unroll 1
    for (int l = 0; l < DEPTH; ++l) {
        const int p0 = 1 + l * PH_PER_LAYER;
        if (EN(1) && IN(p0 + 0)) { LAUNDER();
            if (!defined_NOKV && l == 0) { SchedKV S{(const char*)(ws + WS_MEMN), (const char*)(ws + WS_WKVT), F.G, F.bid}; EpiKV E{(bf16*)(ws + WS_KV)};
                pg8::gemm_phase<EpiKV, SchedKV, true>(F.lds, S, E); }
            SchedDense S; S.init(ws + WS_XB, ws + WS_WINT, D, M, NZ1, F.G, F.bid);
            EpiInProj E{(bf16*)(ws + WS_O), (bf16*)(ws + WS_V), (bf16*)(ws + WS_XBR), args.in[I_B_IN] + (size_t)l * INW};
            pg8::gemm_phase<EpiInProj, SchedDense, true>(F.lds, S, E);
            SEAM(p0 + 0);
        }
        if (EN(2) && IN(p0 + 1)) { LAUNDER();
            for (int it = F.bid; it < 1280 + 1024 + 1024; it += F.G) {
                if (it < 1280) item_lru(F, args, l, it, 1);
                else if (it < 2304) item_spatial(F, args, l, it - 1280);
                else { item_attn(F, l, it - 2304); }
                __syncthreads();
            }
            SEAM(p0 + 1);
        }
        if (EN(3) && IN(p0 + 2)) { LAUNDER(); for (int it = F.bid; it < 1280; it += F.G) { item_lru(F, args, l, it, 2); __syncthreads(); } SEAM(p0 + 2); }
        if (EN(4) && IN(p0 + 3)) { LAUNDER();
            SchedDense S; S.init(ws + WS_XB, ws + WS_WINT + (size_t)NZ1 * D * 2, D, M, NMG, F.G, F.bid);
            EpiGate E{(bf16*)(ws + WS_GA), args.in[I_B_IN] + (size_t)l * INW + NZ1};
            pg8::gemm_phase<EpiGate, SchedDense, true>(F.lds, S, E);
            SEAM(p0 + 3);
        }
        if (EN(5) && IN(p0 + 4)) { LAUNDER();
            SchedY S; S.init(ws, F.G, F.bid); EpiY E{(const bf16*)(ws + WS_GA), (const bf16*)(ws + WS_GBT), (const bf16*)(ws + WS_GC), (bf16*)(ws + WS_Y)};
            pg8::gemm_phase<EpiY, SchedY, false>(F.lds, S, E);
            SEAM(p0 + 4);
        }
        if (EN(6) && IN(p0 + 5)) { LAUNDER();
            const unsigned poison = (__hip_atomic_load(F.ctl + CW_TMO, RLX_AGENT) != 0u) || (F.G != 256);
            SchedDense S; S.init(ws + WS_Y, ws + WS_WOT, D, M, D, F.G, F.bid);
            pg8::PanelStats st{(unsigned*)(ws + WS_XCHG + (size_t)l * 524288), (unsigned*)(F.ctl + CW_SEAM + l * SEAM_BANK), (unsigned*)(F.ctl + CW_TMO), 4, LN_EPS, 0x700u + 0x40u * l};
            EpiLn E{args.out, (bf16*)(ws + WS_X1B), args.in[I_B_O] + l * D, args.in[I_LN1_G] + l * D, args.in[I_LN1_B] + l * D, st, poison};
            if (USE_FUSED_LN) { if (F.G == 256) pg8::gemm_phase<EpiLn, SchedDense, false>(F.lds, S, E); }
            else { EpiF32Res E2{args.out, (float*)(ws + WS_F2), args.in[I_B_O] + l * D}; pg8::gemm_phase<EpiF32Res, SchedDense, true>(F.lds, S, E2);
                 }
            SEAM(p0 + 5);
        }
        if (EN(7) && IN(p0 + 6)) { LAUNDER(); if (!USE_FUSED_LN) ph_ln1(F, args, l); SEAM(p0 + 6); }
        if (EN(8) && IN(p0 + 7)) { LAUNDER(); ph_router(F, args, l, nullptr); __syncthreads(); convert_layer_moe(F, args, l); SEAM(p0 + 7); }
        if (EN(9) && IN(p0 + 8)) { LAUNDER(); ph_gather(F, l); SEAM(p0 + 8); }
        if (EN(10) && IN(p0 + 9)) { LAUNDER();
            SchedMoE S{(const char*)(ws + WS_XG), D, (const char*)(ws + WS_WUPT), (size_t)512 * D * 2, 2, F.ctl + CW_MOE + l * 16 * 64, F.G, F.bid, D};
            EpiUp E{(const float*)(ws + WS_META) + 4 * NPAIR, (bf16*)(ws + WS_H)};
            pg8::gemm_phase<EpiUp, SchedMoE, true>(F.lds, S, E);
            SEAM(p0 + 9);
        }
        if (EN(11) && IN(p0 + 10)) { LAUNDER();
            SchedMoE S{(const char*)(ws + WS_H), DEXP, (const char*)(ws + WS_WDNT), (size_t)D * DEXP * 2, 4, F.ctl + CW_MOE + l * 16 * 64, F.G, F.bid, DEXP};
            EpiPlain E{(bf16*)(ws + WS_F2), D};
            pg8::gemm_phase<EpiPlain, SchedMoE, true>(F.lds, S, E);
            SEAM(p0 + 10);
        }
        if (EN(12) && IN(p0 + 11)) { LAUNDER(); ph_combine(F, args, l); if (l + 1 < DEPTH) { __syncthreads(); convert_layer_main(F, args, l + 1); } SEAM(p0 + 11); }
    }
#undef IN
#undef SEAM
}


#ifndef DBG_CHECKS
#define DBG_CHECKS 0
#endif
constexpr int CW_DBG = 60000;
__device__ __forceinline__ float dbg_dot(const bf16* a, const bf16* b, int K) { float s = 0.f; for (int k = 0; k < K; ++k) s += bf2f(a[k]) * bf2f(b[k]); return s; }
__device__ __forceinline__ float dbg_gelu(float x) { return 0.5f * x * (1.f + tanhf(0.7978845608f * (x + 0.044715f * x * x * x))); }
__device__ __forceinline__ void dbg_cmp(gu32* ctr, float e, float a) { if (!(fabsf(e - a) <= 0.03f + 0.02f * fabsf(e))) __hip_atomic_fetch_add(ctr, 1u, RLX_AGENT); }
__global__ void dbg_kernel(Args args, int which, int l) {
    unsigned char* ws = args.ws; gu32* ctr = (gu32*)(ws + WS_CTL) + CW_DBG + which;
    const long gid = (long)blockIdx.x * blockDim.x + threadIdx.x, gsz = (long)gridDim.x * blockDim.x;
    const bf16* XB = (const bf16*)(ws + WS_XB); const bf16* WINT = (const bf16*)(ws + WS_WINT); const bf16* O = (const bf16*)(ws + WS_O);
    const int NRS = 443;
    if (which == 1) {
        for (long i = gid; i < (long)NRS * NZ1; i += gsz) { const int r = (int)(i / NZ1) * 37, c = (int)(i % NZ1);
            const float z = dbg_dot(XB + (size_t)r * D, WINT + (size_t)c * D, D) + args.in[I_B_IN][(size_t)l * INW + c]; float e, a;
            if (c < 1024) { e = dbg_gelu(z); a = bf2f(O[(size_t)r * LDO + OC_U + c]); }
            else if (c < 2048) { e = dbg_gelu(z); a = bf2f(((const bf16*)(ws + WS_V))[(size_t)r * 1024 + c - 1024]); }
            else if (c < 3328) { e = z; a = bf2f(((const bf16*)(ws + WS_XBR))[(size_t)r * BW + c - 2048]); }
            else if (c < 4608) { e = dbg_gelu(z); a = bf2f(O[(size_t)r * LDO + OC_GB + c - 3328]); }
            else { e = z * 0.0625f; a = bf2f(O[(size_t)r * LDO + OC_Q + c - 4608]); }
            dbg_cmp(ctr, e, a); }
    } else if (which == 2) {
        for (long i = gid; i < (long)2 * 1024 * 2048; i += gsz) { const int ly = (int)(i / (1024 * 2048)), r = (int)((i / 2048) % 1024), c = (int)(i % 2048);
            const float e = dbg_dot((const bf16*)(ws + WS_MEMN) + (size_t)r * D, (const bf16*)(ws + WS_WKVT) + ((size_t)ly * 2048 + c) * D, D);
            dbg_cmp(ctr, e, bf2f(((const bf16*)(ws + WS_KV))[((size_t)ly * 1024 + r) * 2048 + c])); }
    } else if (which == 3) {
        for (long i = gid; i < (long)NRS * NMG; i += gsz) { const int r = (int)(i / NMG) * 37, c = (int)(i % NMG);
            const float z = dbg_dot(XB + (size_t)r * D, WINT + (size_t)(NZ1 + c) * D, D) + args.in[I_B_IN][(size_t)l * INW + NZ1 + c];
            { const float e_ = 1.f / (1.f + expf(-z)); const float a_ = bf2f(((const bf16*)(ws + WS_GA))[(size_t)(c >> 10) * ((size_t)M * 1024) + (size_t)r * 1024 + (c & 1023)]);
              if (!(fabsf(e_ - a_) <= 0.03f + 0.02f * fabsf(e_))) { __hip_atomic_fetch_add((gu32*)(ws + WS_CTL) + CW_DBG + 256 + (r >> 8), 1u, RLX_AGENT); __hip_atomic_fetch_add((gu32*)(ws + WS_CTL) + CW_DBG + 512 + (c >> 8), 1u, RLX_AGENT); __hip_atomic_fetch_add((gu32*)(ws + WS_CTL) + CW_DBG + 768 + (r & 255), 1u, RLX_AGENT); } }
              if (false) dbg_cmp(ctr, 0.f, bf2f(((const bf16*)(ws + WS_GA))[(size_t)(c >> 10) * ((size_t)M * 1024) + (size_t)r * 1024 + (c & 1023)])); }
    } else if (which == 4) {
        const bf16* PT = (const bf16*)(ws + WS_PT);
        for (long i = gid; i < (long)NRS * D; i += gsz) { const int r = (int)(i / D) * 37, c = (int)(i % D);
            const float ga = bf2f(((const bf16*)(ws + WS_GA))[(size_t)r * 1024 + c]), gb = bf2f(((const bf16*)(ws + WS_GBT))[(size_t)r * 1024 + c]), gc = bf2f(((const bf16*)(ws + WS_GC))[(size_t)r * 1024 + c]);
            const float e = ga * dbg_dot(O + (size_t)r * LDO + OC_U, PT + (size_t)c * LDO + OC_U, 1024) + gb * dbg_dot(O + (size_t)r * LDO + OC_GB, PT + (size_t)c * LDO + OC_GB, BW) + gc * dbg_dot(O + (size_t)r * LDO + OC_Q, PT + (size_t)c * LDO + OC_Q, 1024);
            dbg_cmp(ctr, e, bf2f(((const bf16*)(ws + WS_Y))[(size_t)r * 1024 + c])); }
    } else if (which == 5) {
        for (long i = gid; i < (long)NRS * D; i += gsz) { const int r = (int)(i / D) * 37, c = (int)(i % D);
            const float e = dbg_dot((const bf16*)(ws + WS_Y) + (size_t)r * D, (const bf16*)(ws + WS_WOT) + (size_t)c * D, D) + args.in[I_B_O][l * D + c] + ALPHA * args.out[(size_t)r * D + c];
            dbg_cmp(ctr, e, ((const float*)(ws + WS_F2))[(size_t)r * D + c]); }
    } else if (which >= 6 && which <= 8) {
        for (long i = gid; i < (long)NRS * 16; i += gsz) { const int r = (int)(i / 16) * 37, part = (int)(i % 16);
            const float* xr = args.in[I_X] + (size_t)r * D; float s1 = 0.f; for (int k = 0; k < D; ++k) s1 += xr[k]; const float mean = s1 / D; float s2 = 0.f; for (int k = 0; k < D; ++k) { const float d = xr[k] - mean; s2 += d * d; }
            const float rstd = 1.f / sqrtf(s2 / D + LN_EPS);
            for (int c = part * 64; c < part * 64 + 64; ++c) { const float e = (xr[c] - mean) * rstd * args.in[I_LN_IN_G][c] + args.in[I_LN_IN_B][c]; dbg_cmp(ctr, e, bf2f(XB[(size_t)r * D + c])); } }
    } else if (which == 100) {
        if (l == 77) { float c2 = 0.f; for (int k = 0; k < 3; ++k) if (__hip_atomic_load((gu32*)(ws + WS_CTL) + CW_DBG + 6 + k, RLX_AGENT) != 0u) c2 += 0.5f * (float)(1 << k); for (long i = gid; i < (long)M * D; i += gsz) args.out[i] += c2; return; }
        int npm = 0, npn = 0, nrr = 0; for (int k = 0; k < 64; ++k) npm += __hip_atomic_load((gu32*)(ws + WS_CTL) + CW_DBG + 256 + k, RLX_AGENT) != 0u; for (int k = 0; k < 12; ++k) npn += __hip_atomic_load((gu32*)(ws + WS_CTL) + CW_DBG + 512 + k, RLX_AGENT) != 0u;
        for (int k = 0; k < 256; ++k) nrr += __hip_atomic_load((gu32*)(ws + WS_CTL) + CW_DBG + 768 + k, RLX_AGENT) != 0u;
        int v = (l == 0) ? npm : (l == 1) ? npn : nrr; if (v > 38) v = 38; const float cst = 0.5f + 0.25f * (float)v;
        for (long i = gid; i < (long)M * D; i += gsz) args.out[i] += cst;
    }
}

extern "C" void kernel_launch(void* const* d_in, const int* in_sizes, int n_in, void* d_out, int out_size, void* d_ws, size_t ws_size, hipStream_t stream) {
    static int grid = 0;
    if (grid == 0) {
        if (n_in != 35 || in_sizes[0] != M * D || out_size != M * D || ws_size < WS_END) { fprintf(stderr, "kernel_launch: unexpected problem (n_in %d, in0 %d, out %d, ws %zu < %zu); nothing launched\n", n_in, n_in > 0 ? in_sizes[0] : -1, out_size, ws_size, (size_t)WS_END); grid = -1; return; }
        if (hipFuncSetAttribute((const void*)mk_fwd, hipFuncAttributeMaxDynamicSharedMemorySize, LDS_BYTES) != hipSuccess) { fprintf(stderr, "kernel_launch: hipFuncSetAttribute failed\n"); grid = -1; return; }
        int per_cu = 0;
        if (hipOccupancyMaxActiveBlocksPerMultiprocessor(&per_cu, (const void*)mk_fwd, NWAVES * 64, LDS_BYTES) != hipSuccess || per_cu < 1) fprintf(stderr, "kernel_launch: occupancy query reports %d workgroups per CU\n", per_cu);
        (void)hipGetLastError();
        grid = 256;
    }
    if (grid < 0) return;
    if (hipMemsetAsync((char*)d_ws + WS_CTL, 0, CTL_ZERO_BYTES, stream) != hipSuccess) { fprintf(stderr, "kernel_launch: hipMemsetAsync failed\n"); return; }
    Args a{};
    for (int i = 0; i < 35; ++i) a.in[i] = (const float*)d_in[i];
    a.out = (float*)d_out; a.ws = (unsigned char*)d_ws;
#if MK_PER_PHASE
    for (int p = 0; p < N_PHASES; ++p) { a.ph_lo = p; a.ph_hi = p + 1; hipLaunchKernelGGL(mk_fwd, dim3(grid), dim3(NWAVES * 64), LDS_BYTES, stream, a);
#if DBG_CHECKS
        const int l = (p - 1) / PH_PER_LAYER, k = (p - 1) % PH_PER_LAYER;
        if (p >= 1 && l == DBG_LAYER && DBG_CNT == 77) { if (k == 0) hipLaunchKernelGGL(dbg_kernel, dim3(2048), dim3(256), 0, stream, a, 6, l); if (k == 2) hipLaunchKernelGGL(dbg_kernel, dim3(2048), dim3(256), 0, stream, a, 7, l); if (k == 3) hipLaunchKernelGGL(dbg_kernel, dim3(2048), dim3(256), 0, stream, a, 8, l); }
        if (p >= 1 && l == DBG_LAYER) { const int which = (k == 0) ? 1 : (k == 3) ? 3 : (k == 4) ? 4 : (k == 5) ? 5 : 0;
            if (which && (which == DBG_W0 || which == DBG_W1 || which == DBG_W2)) hipLaunchKernelGGL(dbg_kernel, dim3(2048), dim3(256), 0, stream, a, which, l);
            if (k == 0 && l == 0 && (2 == DBG_W0 || 2 == DBG_W1 || 2 == DBG_W2)) hipLaunchKernelGGL(dbg_kernel, dim3(2048), dim3(256), 0, stream, a, 2, 0); }
#endif
    }
#if DBG_CHECKS
    hipLaunchKernelGGL(dbg_kernel, dim3(2048), dim3(256), 0, stream, a, 100, DBG_CNT);
#endif
#else
    a.ph_lo = 0; a.ph_hi = N_PHASES; hipLaunchKernelGGL(mk_fwd, dim3(grid), dim3(NWAVES * 64), LDS_BYTES, stream, a);
#endif
    const hipError_t le = hipPeekAtLastError();
    if (le != hipSuccess) fprintf(stderr, "kernel_launch: launch failed: %s\n", hipGetErrorName(le));
}
```

```cpp
#include <hip/hip_runtime.h>
#include <cstdio>
#include <cstdint>

#ifndef DBG_FSCALE
#define DBG_FSCALE 1.0f
#endif
#ifndef DBG_ZA
#define DBG_ZA 0
#endif
#ifndef DBG_ZB
#define DBG_ZB 0
#endif
#ifndef DBG_ZC
#define DBG_ZC 0
#endif
#ifndef USE_FUSED_LN
#define USE_FUSED_LN 0
#endif
#ifndef USE_MFMA_A
#define USE_MFMA_A 1
#endif
#ifndef USE_MFMA_B
#define USE_MFMA_B 1
#endif
#ifndef USE_MFMA_C
#define USE_MFMA_C 1
#endif
#ifndef MK_PER_PHASE
#define MK_PER_PHASE 0
#endif

namespace pg8 {
#define PG8_LAS __attribute__((address_space(3)))
typedef unsigned short bf16_t;
typedef short bf16x8 __attribute__((ext_vector_type(8)));
typedef float f32x4 __attribute__((ext_vector_type(4)));
typedef float f32x2 __attribute__((ext_vector_type(2)));
typedef unsigned u32x4 __attribute__((ext_vector_type(4)));
typedef unsigned u32x2 __attribute__((ext_vector_type(2)));
constexpr int BM = 256, BK = 64, HALF = 128, HTB = HALF * BK * 2, STAGE_BYTES = 8 * HTB, NXCD = 8, WGM = 8;

__host__ __device__ __forceinline__ int lds_byte(int r, int c) { const int st = (r >> 4) * 2 + (c >> 5), rr = r & 15, cc = c & 31, ob = rr * 64 + cc * 2; return st * 1024 + (ob ^ (((ob >> 9) & 1) << 5)); }
__host__ __device__ __forceinline__ void stage_rc(int b, int& R, int& C) { const int st = b / 1024, sb = b % 1024, swz = sb ^ (((sb >> 9) & 1) << 5); R = (st >> 1) * 16 + swz / 64; C = (st & 1) * 32 + (swz % 64) / 2; }
__host__ __device__ __forceinline__ int perm32(int rho) { const int n = rho >> 4, i = rho & 15; return 8 * (i >> 2) + 4 * n + (i & 3); }

struct Unit { const char* A; const char* B; int K; int pm, pn, seg; };

typedef __bf16 bf16x2_t __attribute__((ext_vector_type(2)));
__device__ __forceinline__ unsigned cvt_pk_bf16(float lo, float hi) { f32x2 v = {lo, hi}; bf16x2_t b = __builtin_convertvector(v, bf16x2_t); return __builtin_bit_cast(unsigned, b); }
__device__ __forceinline__ float bf_lo(unsigned w) { return __uint_as_float(w << 16); }
__device__ __forceinline__ float bf_hi(unsigned w) { return __uint_as_float(w & 0xffff0000u); }
__device__ __forceinline__ float fast_sigmoid(float x) { return __builtin_amdgcn_rcpf(1.0f + __builtin_amdgcn_exp2f(-1.4426950408889634f * x)); }
__device__ __forceinline__ float gelu_tanh(float x) { const float u = x * (1.0f + 0.044715f * x * x); return x * __builtin_amdgcn_rcpf(1.0f + __builtin_amdgcn_exp2f(-2.302208198f * u)); }

template <int ACT  >
__device__ __forceinline__ void store_tile_bf16(const f32x4 (&acc)[2][2][4][2], bf16_t* tile, int ldc, const float* bias, float sc, int wr, int wc, int fr, int fq) {
    const int c0 = wc * 32 + 8 * fq;
    f32x4 bv[2][2];
#pragma unroll
    for (int bj = 0; bj < 2; ++bj)
#pragma unroll
        for (int n = 0; n < 2; ++n) bv[bj][n] = bias ? *(const f32x4*)(bias + c0 + bj * HALF + 4 * n) : (f32x4){0.f, 0.f, 0.f, 0.f};
#pragma unroll
    for (int ai = 0; ai < 2; ++ai)
#pragma unroll
        for (int m = 0; m < 4; ++m) { bf16_t* rowp = tile + (unsigned)((ai * HALF + wr * 64 + m * 16 + fr) * ldc + c0);
#pragma unroll
            for (int bj = 0; bj < 2; ++bj) { f32x4 v0 = acc[ai][bj][m][0] + bv[bj][0], v1 = acc[ai][bj][m][1] + bv[bj][1];
                if (ACT == 1) { for (int e = 0; e < 4; ++e) { v0[e] = gelu_tanh(v0[e]); v1[e] = gelu_tanh(v1[e]); } }
                if (ACT == 2) { for (int e = 0; e < 4; ++e) { v0[e] = fast_sigmoid(v0[e]); v1[e] = fast_sigmoid(v1[e]); } }
                v0 = v0 * sc; v1 = v1 * sc; u32x4 w; w.x = cvt_pk_bf16(v0[0], v0[1]); w.y = cvt_pk_bf16(v0[2], v0[3]); w.z = cvt_pk_bf16(v1[0], v1[1]); w.w = cvt_pk_bf16(v1[2], v1[3]);
                *(u32x4*)(rowp + bj * HALF) = w; } }
}

struct PanelStats {
    unsigned* xbuf;
    unsigned* cnt;
    unsigned* tmo;
    int ntn; float eps; unsigned code;
    __device__ __forceinline__ bool run(const f32x4 (&v)[2][2][4][2], const Unit& u, int wr, int wc, int fr, int fq, PG8_LAS unsigned char* lds, int wid, int lane) const {
        typedef float f32x2v __attribute__((ext_vector_type(2)));
        PG8_LAS f32x2v* P = (PG8_LAS f32x2v*)lds;
        PG8_LAS f32x2v* S = (PG8_LAS f32x2v*)(lds + 8192);
        PG8_LAS unsigned* flag = (PG8_LAS unsigned*)(lds + 8192 + 2048);
#pragma unroll
        for (int ai = 0; ai < 2; ++ai)
#pragma unroll
            for (int m = 0; m < 4; ++m) {
                float s = 0.f;
#pragma unroll
                for (int bj = 0; bj < 2; ++bj)
#pragma unroll
                    for (int n = 0; n < 2; ++n) { const f32x4 x = v[ai][bj][m][n]; s += (x[0] + x[1]) + (x[2] + x[3]); }
                s += __shfl_xor(s, 16); s += __shfl_xor(s, 32);
                const float mw = s * (1.0f / 64.0f); float q = 0.f;
#pragma unroll
                for (int bj = 0; bj < 2; ++bj)
#pragma unroll
                    for (int n = 0; n < 2; ++n) { const f32x4 d = v[ai][bj][m][n] - mw; q += (d[0] * d[0] + d[1] * d[1]) + (d[2] * d[2] + d[3] * d[3]); }
                q += __shfl_xor(q, 16); q += __shfl_xor(q, 32);
                if (fq == 0) P[(ai * HALF + wr * 64 + m * 16 + fr) * 4 + wc] = (f32x2v){mw, q};
            }
        asm volatile("s_waitcnt lgkmcnt(0)" ::: "memory"); __builtin_amdgcn_s_barrier(); asm volatile("" ::: "memory");
        const int row = wid * 32 + (lane & 31);
        if (lane < 32) {
            const f32x2v a = P[row * 4 + 0], b = P[row * 4 + 1], c = P[row * 4 + 2], d = P[row * 4 + 3];
            const float mt = (a.x + b.x + c.x + d.x) * 0.25f;
            const float da = a.x - mt, db = b.x - mt, dc = c.x - mt, dd = d.x - mt;
            const float m2 = (a.y + b.y) + (c.y + d.y) + 64.0f * ((da * da + db * db) + (dc * dc + dd * dd));
            unsigned long long* slot = (unsigned long long*)xbuf + ((size_t)(u.pm * BM + row) * 4 + u.pn);
            __hip_atomic_store(slot, ((unsigned long long)__float_as_uint(m2) << 32) | __float_as_uint(mt), __ATOMIC_RELAXED, __HIP_MEMORY_SCOPE_AGENT);
        }
        asm volatile("s_waitcnt vmcnt(0)" ::: "memory");
        if (lane == 0) __hip_atomic_fetch_add(cnt + 64 * u.pm, 1u, __ATOMIC_RELAXED, __HIP_MEMORY_SCOPE_AGENT);
        if (wid == 0) {
            bool dead = false; const unsigned long long t0 = __builtin_amdgcn_s_memrealtime(); const unsigned want = 8u * (unsigned)ntn;
            for (;;) {
                if ((unsigned)__builtin_amdgcn_readfirstlane(__hip_atomic_load(cnt + 64 * u.pm, __ATOMIC_RELAXED, __HIP_MEMORY_SCOPE_AGENT)) >= want) break;
                if (__builtin_amdgcn_s_memrealtime() - t0 > 2000000ull) {
                    if (lane == 0) { unsigned expect = 0u; __hip_atomic_compare_exchange_strong(tmo + 1, &expect, code | (unsigned)(u.pm & 0xff), __ATOMIC_RELAXED, __ATOMIC_RELAXED, __HIP_MEMORY_SCOPE_AGENT);
                                     __hip_atomic_store(tmo, 1u, __ATOMIC_RELAXED, __HIP_MEMORY_SCOPE_AGENT); }
                    dead = true; break; }
                __builtin_amdgcn_s_sleep(2);
            }
            __builtin_amdgcn_fence(__ATOMIC_ACQUIRE, "agent");
            if (lane == 0) flag[0] = dead ? 1u : 0u;
        }
        asm volatile("s_waitcnt vmcnt(0) lgkmcnt(0)" ::: "memory"); __builtin_amdgcn_s_barrier(); asm volatile("" ::: "memory");
        const bool bad = flag[0] != 0u;
        if (lane < 32) {
            const unsigned long long* slot = (const unsigned long long*)xbuf + (size_t)(u.pm * BM + row) * 4; float mt[4], m2[4]; float ms = 0.f;
#pragma unroll
            for (int t = 0; t < 4; ++t) { if (t < ntn) { const unsigned long long w = __hip_atomic_load(slot + t, __ATOMIC_RELAXED, __HIP_MEMORY_SCOPE_AGENT); mt[t] = __uint_as_float((unsigned)w); m2[t] = __uint_as_float((unsigned)(w >> 32)); } else { mt[t] = 0.f; m2[t] = 0.f; } ms += mt[t]; }
            const float mean = ms / (float)ntn; float q = 0.f;
#pragma unroll
            for (int t = 0; t < 4; ++t) if (t < ntn) { const float dm = mt[t] - mean; q += m2[t] + 256.0f * dm * dm; }
            S[row] = (f32x2v){mean, 1.0f / sqrtf(q / (256.0f * (float)ntn) + eps)};
        }
        asm volatile("s_waitcnt lgkmcnt(0)" ::: "memory"); __builtin_amdgcn_s_barrier(); asm volatile("" ::: "memory");
        return bad;
    }
};

template <class Epi, class Sched, bool ALIGN_EPI>
__device__ __forceinline__ void gemm_phase(PG8_LAS unsigned char* lds, const Sched& S, const Epi& E) {
    int tid_ = threadIdx.x; asm volatile("" : "+v"(tid_));
    const int tid = tid_, wid = __builtin_amdgcn_readfirstlane(tid >> 6), lane = tid & 63, wr = wid >> 2, wc = wid & 3, fr = lane & 15, fq = lane >> 4;
    const size_t kstep = (size_t)(BK * 2);
    const unsigned ldsw = (unsigned)wid * 1024u;
    const int aoff = lds_byte(wr * 64 + fr, fq * 8), boff = lds_byte(wc * 32 + fr, fq * 8);
#define PG8_VOFF(K_, vA_, vB_) do { _Pragma("unroll") for (int _i = 0; _i < 2; ++_i) { int R_, C_; stage_rc(tid * 16 + _i * 8192, R_, C_); const int Rb_ = Epi::PERM ? ((R_ & ~31) + perm32(R_ & 31)) : R_; \
        vA_[_i] = (unsigned)(R_ * (K_) + C_) * 2u; vB_[_i] = (unsigned)(Rb_ * (K_) + C_) * 2u; } } while (0)
#define PG8_SA(b, h) (((b) * 2 + (h)) * HTB)
#define PG8_SB(b, h) ((4 + (b) * 2 + (h)) * HTB)
#define PG8_STAGE(bufoff, gbase, voff) do { _Pragma("unroll") for (int _i = 0; _i < 2; ++_i) \
        __builtin_amdgcn_global_load_lds((const unsigned*)((const char*)(gbase) + (voff)[_i]), (PG8_LAS unsigned*)(lds + (bufoff) + ldsw + _i * 8192), 16, 0, 0); } while (0)
#define PG8_LDA(dst, b, h) do { _Pragma("unroll") for (int m = 0; m < 4; ++m) _Pragma("unroll") for (int k = 0; k < 2; ++k) dst[m][k] = *(const PG8_LAS bf16x8*)(lds + PG8_SA(b, h) + aoff + m * 2048 + k * 1024); } while (0)
#define PG8_LDB(dst, b, h) do { _Pragma("unroll") for (int n = 0; n < 2; ++n) _Pragma("unroll") for (int k = 0; k < 2; ++k) dst[n][k] = *(const PG8_LAS bf16x8*)(lds + PG8_SB(b, h) + boff + n * 2048 + k * 1024); } while (0)
#define PG8_MMA(ai, bj, At, Bt) do { __builtin_amdgcn_s_setprio(1); _Pragma("unroll") for (int m = 0; m < 4; ++m) _Pragma("unroll") for (int n = 0; n < 2; ++n) _Pragma("unroll") for (int k = 0; k < 2; ++k) \
        acc[ai][bj][m][n] = __builtin_amdgcn_mfma_f32_16x16x32_bf16(Bt[n][k], At[m][k], acc[ai][bj][m][n], 0, 0, 0); __builtin_amdgcn_s_setprio(0); } while (0)
#define PG8_WAIT_V(n) asm volatile("s_waitcnt vmcnt(" #n ")" ::: "memory")
#define PG8_WAIT_L(n) asm volatile("s_waitcnt lgkmcnt(" #n ")" ::: "memory")
#define PG8_BAR __builtin_amdgcn_s_barrier()
#define PG8_SCHED __builtin_amdgcn_sched_barrier(0)
    Unit cur, nxt; int ui = 0;
    if (!S.next(0, cur)) return;
    f32x4 acc[2][2][4][2];
#pragma unroll
    for (int a = 0; a < 2; ++a)
#pragma unroll
        for (int b = 0; b < 2; ++b)
#pragma unroll
            for (int m = 0; m < 4; ++m)
#pragma unroll
                for (int n = 0; n < 2; ++n) acc[a][b][m][n] = (f32x4){0.f, 0.f, 0.f, 0.f};
    bf16x8 At[4][2], B0[2][2], B1[2][2];
    unsigned vAc[2], vBc[2]; PG8_VOFF(S.ld, vAc, vBc);
    const char* cA = cur.A; const char* cB = cur.B; const size_t hsC = (size_t)HALF * S.ld * 2;
    S.a_ready(cur);
    PG8_STAGE(PG8_SB(0, 0), cB, vBc); PG8_STAGE(PG8_SB(0, 1), cB + hsC, vBc); PG8_STAGE(PG8_SA(0, 0), cA, vAc); PG8_STAGE(PG8_SA(0, 1), cA + hsC, vAc);
    if (wr == 1) PG8_BAR;
    PG8_WAIT_V(2); PG8_BAR;
    PG8_STAGE(PG8_SB(1, 0), cB + kstep, vBc); PG8_STAGE(PG8_SA(1, 0), cA + kstep, vAc); PG8_STAGE(PG8_SB(1, 1), cB + hsC + kstep, vBc);
    PG8_WAIT_V(6); PG8_BAR;
    for (;;) {
        const bool has_next = S.next(ui + 1, nxt);
        if (!has_next) nxt = cur;
        const char* nA = nxt.A; const char* nB = nxt.B;
        const int nt = cur.K / BK;
        for (int t = 0; t < nt; t += 2) {
            const bool last = (t == nt - 2);
            const char* a1 = cA + (size_t)(t + 1) * kstep;
            const char* a2 = last ? nA : cA + (size_t)(t + 2) * kstep; const char* b2 = last ? nB : cB + (size_t)(t + 2) * kstep;
            const char* a3 = a2 + kstep; const char* b3 = b2 + kstep;
            if (last && has_next) S.a_ready(nxt);
            PG8_LDB(B0, 0, 0); PG8_LDB(B1, 0, 1); PG8_SCHED; PG8_LDA(At, 0, 0); PG8_STAGE(PG8_SA(1, 1), a1 + hsC, vAc);
            PG8_WAIT_V(8); PG8_WAIT_L(0); PG8_BAR; PG8_MMA(0, 0, At, B0); PG8_MMA(0, 1, At, B1); PG8_BAR; PG8_SCHED;
            PG8_LDA(At, 0, 1); PG8_STAGE(PG8_SB(0, 0), b2, vBc); PG8_STAGE(PG8_SB(0, 1), b2 + hsC, vBc); PG8_STAGE(PG8_SA(0, 0), a2, vAc);
            PG8_WAIT_V(8); PG8_WAIT_L(0); PG8_BAR; PG8_MMA(1, 0, At, B0); PG8_MMA(1, 1, At, B1); PG8_BAR; PG8_SCHED;
            PG8_LDB(B0, 1, 0); PG8_LDB(B1, 1, 1); PG8_SCHED; PG8_LDA(At, 1, 0); PG8_STAGE(PG8_SA(0, 1), a2 + hsC, vAc);
            PG8_WAIT_V(8); PG8_WAIT_L(0); PG8_BAR; PG8_MMA(0, 0, At, B0); PG8_MMA(0, 1, At, B1); PG8_BAR; PG8_SCHED;
            PG8_LDA(At, 1, 1); PG8_STAGE(PG8_SB(1, 0), b3, vBc); PG8_STAGE(PG8_SB(1, 1), b3 + hsC, vBc); PG8_STAGE(PG8_SA(1, 0), a3, vAc);
            PG8_WAIT_V(8); PG8_WAIT_L(0); PG8_BAR; PG8_MMA(1, 0, At, B0); PG8_MMA(1, 1, At, B1); PG8_BAR; PG8_SCHED;
        }
        if constexpr (ALIGN_EPI) { if (wr == 0) PG8_BAR; }
        if constexpr (!Epi::AFTER_DRAIN) { int fr_ = fr, fq_ = fq; asm volatile("" : "+v"(fr_), "+v"(fq_));
            (void)E(acc, cur, wr, wc, fr_, fq_); S.done(cur); }
        if (!has_next) break;
        if constexpr (!Epi::KEEP) {
#pragma unroll
            for (int a = 0; a < 2; ++a)
#pragma unroll
                for (int b = 0; b < 2; ++b)
#pragma unroll
                    for (int m = 0; m < 4; ++m)
#pragma unroll
                        for (int n = 0; n < 2; ++n) acc[a][b][m][n] = (f32x4){0.f, 0.f, 0.f, 0.f};
        }
        cur = nxt; cA = nA; cB = nB; ++ui;
        if constexpr (ALIGN_EPI) { if (wr == 1) PG8_BAR; }
    }
    PG8_WAIT_V(0);
    if constexpr (!ALIGN_EPI) { if (wr == 0) PG8_BAR; }
    PG8_BAR;
    if constexpr (Epi::AFTER_DRAIN) { int fr_ = fr, fq_ = fq; asm volatile("" : "+v"(fr_), "+v"(fq_)); E.fused(acc, cur, wr, wc, fr_, fq_, lds, wid, lane); S.done(cur); }
#undef PG8_VOFF
#undef PG8_SA
#undef PG8_SB
#undef PG8_STAGE
#undef PG8_LDA
#undef PG8_LDB
#undef PG8_MMA
#undef PG8_WAIT_V
#undef PG8_WAIT_L
#undef PG8_BAR
#undef PG8_SCHED
}
}

constexpr int NB = 4, SEQ = 4096, D = 1024, M = NB * SEQ, NMEM = 256, DEPTH = 2;
constexpr int AW = 1024, BW = 1280, CW = 1024, INW = 8704, NZ1 = 5632  , NMG = 3072;
constexpr int NEXP = 16, DEXP = 256, NPAIR = 2 * M, MOE_ROWS = 36864  ;
constexpr float LN_EPS = 1e-5f, ALPHA = 1.4142135623730951f;
constexpr float QSCALE = USE_MFMA_C ? 0.0625f * 1.4426950408889634f : 0.0625f;

constexpr size_t MiB = 1u << 20;
constexpr size_t WS_CTL = 0, CTL_ZERO_BYTES = 1 * MiB;
constexpr size_t WS_XCHG = 1 * MiB;
constexpr size_t WS_SUMM = 2 * MiB;
constexpr size_t WS_META = WS_SUMM + 1310720;
constexpr size_t WS_SMALLW = 4 * MiB;
constexpr size_t WS_WAT = WS_SMALLW, WS_WXT = WS_SMALLW + 327680, WS_WSB = WS_SMALLW + 655360;
constexpr size_t WS_KV = 5 * MiB;
constexpr size_t WS_VT = WS_KV + 4 * MiB;
constexpr size_t WS_WINT = 13 * MiB;
constexpr size_t WS_PT = 30 * MiB;
constexpr size_t WS_WOT = WS_PT + 6815744;
constexpr size_t WS_XB = 39 * MiB;
constexpr int LDO = 3328;
constexpr size_t WS_O = 71 * MiB, WS_V = 175 * MiB, WS_XBR = 207 * MiB, WS_WMOE = 247 * MiB, WS_END = 271 * MiB;
constexpr int OC_U = 0, OC_GB = 1024, OC_Q = 2304;
constexpr size_t WS_GA = WS_V, WS_GBT = WS_V + 32 * MiB, WS_GC = WS_V + 64 * MiB;
constexpr size_t WS_Y = WS_XB, WS_X1B = WS_O, WS_XG = WS_V, WS_H = WS_XB, WS_F2 = WS_O + 32 * MiB;
constexpr size_t WS_MEMN = WS_WMOE, WS_WKVT = WS_WMOE + 2 * MiB;
constexpr size_t WS_WUPT = WS_WMOE, WS_WDNT = WS_WMOE + 16 * MiB;
static_assert(WS_WOT + 2 * MiB <= WS_XB && WS_META + 4 * 131072 + 147456 <= WS_SMALLW && WS_XG + (size_t)MOE_ROWS * 2048 <= WS_WMOE && WS_F2 + (size_t)MOE_ROWS * 2048 <= WS_V && WS_H + (size_t)MOE_ROWS * 512 <= WS_O && WS_O + (size_t)M * LDO * 2 <= WS_V, "d_ws map");
constexpr int CW_TMO = 0, CW_CODE = 1, CW_BAR = 4096, CW_SEAM = 16384, SEAM_BANK = 64 * 64, CW_MOE = 40960;
static_assert((CW_MOE + 2 * 16 * 64) * 4 <= (int)CTL_ZERO_BYTES, "ctl");

constexpr int RING_BYTES = 131072, LDSCTL_OFF = RING_BYTES, MISC_OFF = LDSCTL_OFF + 320, LDS_BYTES = 147456;
constexpr int NWAVES = 8;

#define GAS __attribute__((address_space(1)))
#define LAS __attribute__((address_space(3)))
typedef unsigned short bf16;
typedef unsigned v4u __attribute__((ext_vector_type(4)));
typedef unsigned v2u __attribute__((ext_vector_type(2)));
typedef float f32x4 __attribute__((ext_vector_type(4)));
typedef GAS unsigned gu32;
#define RLX_AGENT __ATOMIC_RELAXED, __HIP_MEMORY_SCOPE_AGENT
#define LDS_WAIT() asm volatile("s_waitcnt lgkmcnt(0)" ::: "memory")
#define VM_WAIT() asm volatile("s_waitcnt vmcnt(0)" ::: "memory")
__device__ __forceinline__ unsigned f2bf(float f) { unsigned u = __builtin_bit_cast(unsigned, f); return (u + 0x7fffu + ((u >> 16) & 1u)) >> 16; }
__device__ __forceinline__ unsigned pk2(float lo, float hi) { return f2bf(lo) | (f2bf(hi) << 16); }
__device__ __forceinline__ float bf2f(bf16 b) { return __uint_as_float((unsigned)b << 16); }
using pg8::bf_lo; using pg8::bf_hi;

#define XB_TMO      128
#define XB_XCNT(j)  (256  + 64 * (j))
#define XB_XSUB(j)  (1280 + 64 * (j))
#define XB_XGEN(j)  (2304 + 64 * (j))
#define XB_TOP      3328
#define XB_TOPGEN   3392
#define XCD_BAR_WORDS 3456
#define XB_SPIN_CAP (1u << 18)
__device__ __forceinline__ unsigned xb_ld(unsigned* p)              { return __hip_atomic_load(p, __ATOMIC_RELAXED, __HIP_MEMORY_SCOPE_AGENT); }
__device__ __forceinline__ unsigned xb_add(unsigned* p, unsigned v) { return __hip_atomic_fetch_add(p, v, __ATOMIC_RELAXED, __HIP_MEMORY_SCOPE_AGENT); }
__device__ __forceinline__ unsigned xb_xcc_id() { return (unsigned)__builtin_amdgcn_s_getreg((3 << 11) | 20) & 0xFu; }
#define XB_SPIN(cond, bar) do { unsigned _sp = 0; while (cond) { __builtin_amdgcn_s_sleep(1); \
    if ((++_sp & 255u) == 0u) { if (xb_ld(&(bar)[XB_TMO])) break; if (_sp > XB_SPIN_CAP) { atomicAdd(&(bar)[XB_TMO], 1u); break; } } } } while (0)
struct XcdBarrier { unsigned* bar; unsigned x; volatile LAS unsigned* st; };
__device__ __forceinline__ XcdBarrier xcd_barrier_post(unsigned* bar, volatile LAS unsigned* st) {
    XcdBarrier b; b.bar = bar; b.x = xb_xcc_id(); b.st = st;
    if (threadIdx.x == 0) (void)xb_add(&bar[XB_XCNT(b.x)], 1u);
    return b;
}
__device__ __forceinline__ void xcd_barrier_complete(unsigned* bar, unsigned x, unsigned& nloc, unsigned& nx) {
    const unsigned G = gridDim.x * gridDim.y * gridDim.z;
    unsigned sum, cnt, mine, sp = 0u;
    for (;;) {
        sum = 0u; cnt = 0u; mine = 0u;
#pragma unroll
        for (unsigned j = 0; j < 16; ++j) { const unsigned c = xb_ld(&bar[XB_XCNT(j)]); sum += c; cnt += (c > 0u) ? 1u : 0u; mine = (j == x) ? c : mine; }
        if (sum == G) break;
        __builtin_amdgcn_s_sleep(1);
        if ((++sp & 255u) == 0u) { if (xb_ld(&bar[XB_TMO])) break; if (sp > XB_SPIN_CAP) { atomicAdd(&bar[XB_TMO], 1u); break; } }
    }
    nloc = mine > 0u ? mine : 1u; nx = cnt > 0u ? cnt : 1u;
}
__device__ __forceinline__ void xcd_barrier(const XcdBarrier& b) {
    asm volatile("s_waitcnt vmcnt(0)" ::: "memory");
    __syncthreads();
    if (threadIdx.x == 0) {
        unsigned* bar = b.bar;
        __builtin_amdgcn_s_waitcnt(0);
        unsigned nloc = b.st[0], nx = b.st[1];
        if (nloc == 0u) { xcd_barrier_complete(bar, b.x, nloc, nx); b.st[0] = nloc; b.st[1] = nx; }
        const unsigned old = xb_add(&bar[XB_XSUB(b.x)], 1u);
        const unsigned gen = old / nloc;
        if (old + 1u == (gen + 1u) * nloc) {
            __builtin_amdgcn_fence(__ATOMIC_RELEASE, "agent");
            asm volatile("s_waitcnt vmcnt(0)" ::: "memory");
            const unsigned og = xb_add(&bar[XB_TOP], 1u);
            const unsigned tg = og / nx;
            if (og + 1u == (tg + 1u) * nx) xb_add(&bar[XB_TOPGEN], 1u);
            else XB_SPIN(xb_ld(&bar[XB_TOPGEN]) == tg, bar);
            __builtin_amdgcn_fence(__ATOMIC_ACQUIRE, "agent");
            xb_add(&bar[XB_XGEN(b.x)], 1u);
            asm volatile("s_waitcnt vmcnt(0)" ::: "memory");
        } else {
            XB_SPIN(xb_ld(&bar[XB_XGEN(b.x)]) == gen, bar);
            __builtin_amdgcn_fence(__ATOMIC_ACQUIRE, "agent");
            asm volatile("s_waitcnt vmcnt(0)" ::: "memory");
        }
    }
    __syncthreads();
}

struct Args { const float* in[35]; float* out; unsigned char* ws; int ph_lo, ph_hi; };
enum InIdx { I_X = 0, I_MEM, I_LN_IN_G, I_LN_IN_B, I_LN_MEM_G, I_LN_MEM_B, I_W_IN, I_B_IN, I_LN_V_G, I_LN_V_B, I_W_S, I_B_S, I_CONV_W, I_CONV_B, I_W_A, I_B_A, I_W_X, I_B_X, I_LAM,
             I_W_KV, I_P_A, I_P_B, I_P_C, I_W_O, I_B_O, I_LN1_G, I_LN1_B, I_W_RG, I_B_RG, I_W_RE, I_B_RE, I_W_UP, I_W_DOWN, I_LN2_G, I_LN2_B };
struct Frame {
    LAS unsigned char* lds; gu32* ctl; unsigned char* ws;
    int tid, lane, wave, G, bid;
};

__device__ __forceinline__ float wave_sum(float v) {
#pragma unroll
    for (int o = 1; o < 64; o <<= 1) v += __shfl_xor(v, o);
    return v;
}
__device__ __forceinline__ float wave_max(float v) {
#pragma unroll
    for (int o = 1; o < 64; o <<= 1) v = fmaxf(v, __shfl_xor(v, o));
    return v;
}

__device__ __forceinline__ void tr_item(const float* W, int K, int N, bf16* WT, int ldo, int mode, LAS float* scr, int item, int lane) {
    const int nblk = N / 32, kb = item / nblk, nb = item % nblk, k0 = 64 * kb, n0 = 32 * nb;
    int r0 = n0;
    if (mode == 1) { const int nn = n0 & 255; r0 = (nn >> 7) * 256 + (n0 >> 8) * 128 + (nn & 127); }
#pragma unroll 8
    for (int i = 0; i < 32; ++i) { const int kk = 2 * i + (lane >> 5); scr[kk * 33 + (lane & 31)] = W[(size_t)(k0 + kk) * N + n0 + (lane & 31)]; }
    LDS_WAIT(); asm volatile("" ::: "memory");
    const int c = lane & 7;
#pragma unroll
    for (int j = 0; j < 4; ++j) { const int n = (lane >> 3) + 8 * j; const LAS float* s = scr + (8 * c) * 33 + n;
        v4u o; o.x = pk2(s[0 * 33], s[1 * 33]); o.y = pk2(s[2 * 33], s[3 * 33]); o.z = pk2(s[4 * 33], s[5 * 33]); o.w = pk2(s[6 * 33], s[7 * 33]);
        *(GAS v4u*)(WT + (size_t)(r0 + n) * ldo + k0 + 8 * c) = o; }
    LDS_WAIT(); asm volatile("" ::: "memory");
}
__device__ __forceinline__ void tr_job(const Frame& F, LAS float* scr, const float* W, int K, int N, bf16* WT, int ldo, int mode, int& it_base) {
    const int NGW = F.G * NWAVES, gw = F.bid * NWAVES + F.wave;
    const int n = (K / 64) * (N / 32);
    int first = (gw - (it_base % NGW) + NGW) % NGW;
    for (int idx = first; idx < n; idx += NGW) tr_item(W, K, N, WT, ldo, mode, scr, idx, F.lane);
    it_base += n;
}
__device__ __forceinline__ void convert_layer_main(const Frame& F, const Args& a, int l) {
    LAS float* scr = (LAS float*)(F.lds + F.wave * 16384);
    int base = 0;
    tr_job(F, scr, a.in[I_W_IN] + (size_t)l * D * INW, D, INW, (bf16*)(F.ws + WS_WINT), D, 0, base);
    tr_job(F, scr, a.in[I_P_A] + (size_t)l * AW * D, AW, D, (bf16*)(F.ws + WS_PT) + OC_U, LDO, 0, base);
    tr_job(F, scr, a.in[I_P_B] + (size_t)l * BW * D, BW, D, (bf16*)(F.ws + WS_PT) + OC_GB, LDO, 0, base);
    tr_job(F, scr, a.in[I_P_C] + (size_t)l * CW * D, CW, D, (bf16*)(F.ws + WS_PT) + OC_Q, LDO, 0, base);
    tr_job(F, scr, a.in[I_W_O] + (size_t)l * D * D, D, D, (bf16*)(F.ws + WS_WOT), D, 0, base);
    for (int h = 0; h < 10; ++h) { tr_job(F, scr, a.in[I_W_A] + (size_t)(l * 10 + h) * 16384, 128, 128, (bf16*)(F.ws + WS_WAT) + h * 16384, 128, 0, base);
                                   tr_job(F, scr, a.in[I_W_X] + (size_t)(l * 10 + h) * 16384, 128, 128, (bf16*)(F.ws + WS_WXT) + h * 16384, 128, 0, base); }
    { const float* wsrc = a.in[I_W_S] + (size_t)l * 8 * 16384; bf16* wdst = (bf16*)(F.ws + WS_WSB);
      for (int i = F.bid * (NWAVES * 64) + F.tid; i < 8 * 16384; i += F.G * NWAVES * 64) { const int t = (i >> 7) & 127, sx = i & 127; wdst[i] = (bf16)f2bf(sx <= t ? wsrc[i] : 0.f); } }
}
__device__ __forceinline__ void convert_layer_moe(const Frame& F, const Args& a, int l) {
    LAS float* scr = (LAS float*)(F.lds + F.wave * 16384);
    int base = 0;
    for (int e = 0; e < NEXP; ++e) tr_job(F, scr, a.in[I_W_UP] + (size_t)(l * NEXP + e) * D * 512, D, 512, (bf16*)(F.ws + WS_WUPT) + (size_t)e * 512 * D, D, 1, base);
    for (int e = 0; e < NEXP; ++e) tr_job(F, scr, a.in[I_W_DOWN] + (size_t)(l * NEXP + e) * DEXP * D, DEXP, D, (bf16*)(F.ws + WS_WDNT) + (size_t)e * D * DEXP, DEXP, 0, base);
}
__device__ __forceinline__ void ln_row_store(f32x4 (&v)[4], int lane, const float* g, const float* b, float* o32, bf16* o16) {
    float s = 0.f;
#pragma unroll
    for (int j = 0; j < 4; ++j) s += (v[j].x + v[j].y) + (v[j].z + v[j].w);
    const float mean = wave_sum(s) * (1.f / 1024.f); float s2 = 0.f;
#pragma unroll
    for (int j = 0; j < 4; ++j) { v[j] = v[j] - mean; s2 += (v[j].x * v[j].x + v[j].y * v[j].y) + (v[j].z * v[j].z + v[j].w * v[j].w); }
    const float rstd = 1.f / sqrtf(wave_sum(s2) * (1.f / 1024.f) + LN_EPS);
#pragma unroll
    for (int j = 0; j < 4; ++j) { const f32x4 gv = ((const f32x4*)g)[64 * j + lane], bv = ((const f32x4*)b)[64 * j + lane]; const f32x4 o = v[j] * rstd * gv + bv;
        if (o32) ((f32x4*)o32)[64 * j + lane] = o;
        if (o16) ((v2u*)o16)[64 * j + lane] = (v2u){pk2(o.x, o.y), pk2(o.z, o.w)}; }
}

struct SchedDense {
    const char* A; const char* Bt; int K, ld, nM, nN, nwg, G, c;
    __device__ void init(const void* A_, const void* Bt_, int K_, int M_, int N_, int G_, int c_) { A = (const char*)A_; Bt = (const char*)Bt_; K = K_; ld = K_; nM = M_ / 256; nN = N_ / 256; nwg = nM * nN; G = G_; c = c_; }
    __device__ __forceinline__ bool next(int i, pg8::Unit& u) const {
        const long L = (long)i * G + c; if (L >= nwg) return false;
        int wgid = (int)L; { const int q = nwg / 8, r = nwg % 8, xcd = wgid % 8, off = wgid / 8; wgid = (xcd < r ? xcd * (q + 1) : r * (q + 1) + (xcd - r) * q) + off; }
        const int nig = 8 * nN, gid = wgid / nig, fm = gid * 8, gsz = (nM - fm) < 8 ? (nM - fm) : 8;
        u.pm = fm + ((wgid % nig) % gsz); u.pn = (wgid % nig) / gsz; u.K = K; u.seg = 0;
        u.A = A + (size_t)u.pm * 256 * K * 2; u.B = Bt + (size_t)u.pn * 256 * K * 2; return true;
    }
    __device__ __forceinline__ void a_ready(const pg8::Unit&) const {}
    __device__ __forceinline__ void done(const pg8::Unit&) const {}
};
struct SchedKV {
    const char* A; const char* Bt; int G, c; static constexpr int ld = D;
    __device__ __forceinline__ bool next(int i, pg8::Unit& u) const {
        const int L = i * G + (G - 1 - c); if (L >= 64) return false;
        u.seg = L >> 5; u.pm = (L & 31) & 3; u.pn = (L & 31) >> 2; u.K = D;
        u.A = A + (size_t)u.pm * 256 * D * 2; u.B = Bt + ((size_t)u.seg * 2048 + (size_t)u.pn * 256) * D * 2; return true;
    }
    __device__ __forceinline__ void a_ready(const pg8::Unit&) const {}
    __device__ __forceinline__ void done(const pg8::Unit&) const {}
};
struct SchedY {
    const char *A, *B; int pm, pn; bool ok; static constexpr int ld = LDO;
    __device__ void init(const unsigned char* ws, int G, int c) { SchedDense s; s.init(nullptr, nullptr, D, M, D, G, c); pg8::Unit u; ok = s.next(0, u) && G == 256; pm = u.pm; pn = u.pn;
        A = (const char*)(ws + WS_O) + (size_t)pm * 256 * LDO * 2; B = (const char*)(ws + WS_PT) + (size_t)pn * 256 * LDO * 2; }
    __device__ __forceinline__ bool next(int i, pg8::Unit& u) const {
        if (!ok || i >= 3) return false;
        const int k0 = (i == 0) ? OC_U : (i == 1) ? OC_GB : OC_Q;
        u.pm = pm; u.pn = pn; u.seg = i; u.K = (i == 1) ? BW : 1024; u.A = A + k0 * 2; u.B = B + k0 * 2; return true;
    }
    __device__ __forceinline__ void a_ready(const pg8::Unit&) const {}
    __device__ __forceinline__ void done(const pg8::Unit&) const {}
};
struct SchedMoE {
    const char* A; int K; const char* W; size_t wstride; int ncol; gu32* cnt; int G, c; int ld;
    __device__ __forceinline__ bool next(int i, pg8::Unit& u) const {
        const int L = i * G + c, rt = L / ncol, pn = L % ncol;
        int acc = 0, e = -1;
#pragma unroll 1
        for (int k = 0; k < NEXP; ++k) { const int n = (int)((__hip_atomic_load(cnt + 64 * k, RLX_AGENT) + 255u) >> 8); if (e < 0 && rt < acc + n) e = k; acc += n; }
        e = __builtin_amdgcn_readfirstlane(e);
        if (e < 0) return false;
        u.pm = rt; u.pn = pn; u.seg = e; u.K = K;
        u.A = A + (size_t)rt * 256 * K * 2; u.B = W + (size_t)e * wstride + (size_t)pn * 256 * K * 2; return true;
    }
    __device__ __forceinline__ void a_ready(const pg8::Unit&) const {}
    __device__ __forceinline__ void done(const pg8::Unit&) const {}
};

using pg8::f32x2; using pg8::u32x4; using pg8::u32x2; using pg8::Unit; using pg8::HALF;
struct EpiInProj {
    static constexpr bool PERM = true, AFTER_DRAIN = false, KEEP = false;
    bf16 *O_, *V, *XBR; const float* bias;
    __device__ __forceinline__ bool operator()(f32x4 (&acc)[2][2][4][2], const Unit& u, int wr, int wc, int fr, int fq) const {
        const int t = u.pn; bf16* O; int ldc, ct, act; float sc = 1.f;
        if (t < 4) { O = O_ + OC_U; ldc = LDO; ct = t; act = 1; }
        else if (t < 8) { O = V; ldc = 1024; ct = t - 4; act = 1; }
        else if (t < 13) { O = XBR; ldc = BW; ct = t - 8; act = 0; }
        else if (t < 18) { O = O_ + OC_GB; ldc = LDO; ct = t - 13; act = 1; }
        else { O = O_ + OC_Q; ldc = LDO; ct = t - 18; act = 0; sc = QSCALE; }
        bf16* tile = O + (size_t)u.pm * 256 * ldc + ct * 256; const float* b = bias + t * 256;
        if (act == 1) pg8::store_tile_bf16<1>(acc, tile, ldc, b, sc, wr, wc, fr, fq); else pg8::store_tile_bf16<0>(acc, tile, ldc, b, sc, wr, wc, fr, fq);
        return false;
    }
};
struct EpiGate {
    static constexpr bool PERM = true, AFTER_DRAIN = false, KEEP = false;
    bf16* G0; const float* bias;
    __device__ __forceinline__ bool operator()(f32x4 (&acc)[2][2][4][2], const Unit& u, int wr, int wc, int fr, int fq) const {
        const int t = u.pn; bf16* tile = G0 + (size_t)(t >> 2) * ((size_t)M * 1024) + (size_t)u.pm * 256 * 1024 + (t & 3) * 256;
        pg8::store_tile_bf16<2>(acc, tile, 1024, bias + t * 256, 1.f, wr, wc, fr, fq); return false;
    }
};
struct EpiKV {
    static constexpr bool PERM = true, AFTER_DRAIN = false, KEEP = false;
    bf16* KV;
    __device__ __forceinline__ bool operator()(f32x4 (&acc)[2][2][4][2], const Unit& u, int wr, int wc, int fr, int fq) const {
        const int hd = u.pn & 3; bf16* blk = KV + ((size_t)(u.seg * 4 + u.pm) * 4 + hd) * 65536 + (u.pn >= 4 ? (size_t)2097152 : 0);
        if (u.pn < 4) { pg8::store_tile_bf16<0>(acc, blk, 256, nullptr, 1.f, wr, wc, fr, fq); return false; }
        const int c0 = wc * 32 + 8 * fq;
#pragma unroll
        for (int ai = 0; ai < 2; ++ai)
#pragma unroll
            for (int m = 0; m < 4; ++m) { const int key = ai * HALF + wr * 64 + m * 16 + fr;
#pragma unroll
                for (int bj = 0; bj < 2; ++bj)
#pragma unroll
                    for (int n = 0; n < 2; ++n)
#pragma unroll
                        for (int e = 0; e < 4; ++e) blk[(unsigned)((c0 + bj * HALF + 4 * n + e) * 256 + key)] = (bf16)f2bf(acc[ai][bj][m][n][e]); }
        return false;
    }
};
struct EpiPlain {
    static constexpr bool PERM = true, AFTER_DRAIN = false, KEEP = false;
    bf16* O; int ldc;
    __device__ __forceinline__ bool operator()(f32x4 (&acc)[2][2][4][2], const Unit& u, int wr, int wc, int fr, int fq) const {
        pg8::store_tile_bf16<0>(acc, O + (size_t)u.pm * 256 * ldc + u.pn * 256, ldc, nullptr, 1.f, wr, wc, fr, fq); return false;
    }
};
struct EpiY {
    static constexpr bool PERM = true, AFTER_DRAIN = false, KEEP = true;
    const bf16 *GA, *GB_, *GC; bf16* Y;
    __device__ __forceinline__ bool operator()(f32x4 (&acc)[2][2][4][2], const Unit& u, int wr, int wc, int fr, int fq) const {
        int pm_ = u.pm, pn_ = u.pn; asm volatile("" : "+s"(pm_), "+s"(pn_));
        const unsigned t0 = (unsigned)(pm_ * 256 * 1024 + pn_ * 256 + wc * 32 + 8 * fq);
        const bool fin = (u.seg == 2);
        const GAS bf16* num = (const GAS bf16*)((u.seg == 0) ? GA : (u.seg == 1) ? GB_ : GC); const GAS bf16* den = (const GAS bf16*)((u.seg == 0) ? GB_ : GC);
#pragma unroll
        for (int ai = 0; ai < 2; ++ai)
#pragma unroll
            for (int m = 0; m < 4; ++m) { const unsigned ro = t0 + (unsigned)(ai * HALF + wr * 64 + m * 16 + fr) * 1024u;
#pragma unroll
                for (int bj = 0; bj < 2; ++bj) {
                    const u32x4 nw = *(const GAS u32x4*)(num + ro + bj * HALF); const u32x4 dw = *(const GAS u32x4*)(den + ro + bj * HALF);
#define EPIY_F(nv, dv) ((nv) * (fin ? 1.0f : __builtin_amdgcn_rcpf(fmaxf((dv), 1e-6f))))
                    acc[ai][bj][m][0][0] *= EPIY_F(bf_lo(nw.x), bf_lo(dw.x)); acc[ai][bj][m][0][1] *= EPIY_F(bf_hi(nw.x), bf_hi(dw.x));
                    acc[ai][bj][m][0][2] *= EPIY_F(bf_lo(nw.y), bf_lo(dw.y)); acc[ai][bj][m][0][3] *= EPIY_F(bf_hi(nw.y), bf_hi(dw.y));
                    acc[ai][bj][m][1][0] *= EPIY_F(bf_lo(nw.z), bf_lo(dw.z)); acc[ai][bj][m][1][1] *= EPIY_F(bf_hi(nw.z), bf_hi(dw.z));
                    acc[ai][bj][m][1][2] *= EPIY_F(bf_lo(nw.w), bf_lo(dw.w)); acc[ai][bj][m][1][3] *= EPIY_F(bf_hi(nw.w), bf_hi(dw.w));
#undef EPIY_F
                }
                asm volatile("" ::: "memory"); }
        if (fin) {
            GAS bf16* Yg = (GAS bf16*)Y;
#pragma unroll
            for (int ai = 0; ai < 2; ++ai)
#pragma unroll
                for (int m = 0; m < 4; ++m) { const unsigned ro = t0 + (unsigned)(ai * HALF + wr * 64 + m * 16 + fr) * 1024u;
#pragma unroll
                    for (int bj = 0; bj < 2; ++bj) { const f32x4 v0 = acc[ai][bj][m][0], v1 = acc[ai][bj][m][1];
                        u32x4 w; w.x = pg8::cvt_pk_bf16(v0[0], v0[1]); w.y = pg8::cvt_pk_bf16(v0[2], v0[3]); w.z = pg8::cvt_pk_bf16(v1[0], v1[1]); w.w = pg8::cvt_pk_bf16(v1[2], v1[3]);
                        *(GAS u32x4*)(Yg + ro + bj * HALF) = w; } }
        }
        return !fin;
    }
};
struct EpiLn {
    static constexpr bool PERM = false, AFTER_DRAIN = true, KEEP = false;
    float* X; bf16* XBo; const float *bias, *g, *b; pg8::PanelStats st; unsigned poison;
    __device__ __forceinline__ void fused(f32x4 (&acc)[2][2][4][2], const Unit& u, int wr, int wc, int fr, int fq, PG8_LAS unsigned char* lds, int wid, int lane) const {
        typedef float f32x2v __attribute__((ext_vector_type(2)));
        const PG8_LAS f32x2v* S = (const PG8_LAS f32x2v*)(lds + 8192);
        const int col0 = u.pn * 256 + wc * 32 + 4 * fq;
#pragma unroll
        for (int ai = 0; ai < 2; ++ai)
#pragma unroll
            for (int m = 0; m < 4; ++m) { const unsigned off = (unsigned)(u.pm * 256 + ai * HALF + wr * 64 + m * 16 + fr) * 1024u + col0;
#pragma unroll
                for (int bj = 0; bj < 2; ++bj)
#pragma unroll
                    for (int n = 0; n < 2; ++n) { const f32x4 xs = *(const f32x4*)(X + off + bj * HALF + n * 16); const f32x4 bv = *(const f32x4*)(bias + col0 + bj * HALF + n * 16);
                        acc[ai][bj][m][n] = acc[ai][bj][m][n] + bv + xs * ALPHA; }
                asm volatile("" : "+v"(acc[ai][0][m][0]), "+v"(acc[ai][0][m][1]), "+v"(acc[ai][1][m][0]), "+v"(acc[ai][1][m][1]));
                if (m & 1) asm volatile("" ::: "memory"); }
        const bool bad = st.run(acc, u, wr, wc, fr, fq, lds, wid, lane) || poison != 0u;
        const float qnan = __builtin_nanf("");
#pragma unroll
        for (int bj = 0; bj < 2; ++bj)
#pragma unroll
            for (int n = 0; n < 2; ++n) { const f32x4 gv = *(const f32x4*)(g + col0 + bj * HALF + n * 16), bb = *(const f32x4*)(b + col0 + bj * HALF + n * 16);
#pragma unroll
                for (int ai = 0; ai < 2; ++ai)
#pragma unroll
                    for (int m = 0; m < 4; ++m) { const int r = ai * HALF + wr * 64 + m * 16 + fr; const f32x2v sr = S[r]; const unsigned off = (unsigned)(u.pm * 256 + r) * 1024u + col0 + bj * HALF + n * 16;
                        f32x4 o = (acc[ai][bj][m][n] - sr.x) * sr.y * gv + bb; if (bad) o = (f32x4){qnan, qnan, qnan, qnan};
                        *(f32x4*)(X + off) = o; *(u32x2*)(XBo + off) = (u32x2){pg8::cvt_pk_bf16(o[0], o[1]), pg8::cvt_pk_bf16(o[2], o[3])}; } }
    }
};
struct EpiF32Res {
    static constexpr bool PERM = false, AFTER_DRAIN = false, KEEP = false;
    const float* X; float* T; const float* bias;
    __device__ __forceinline__ bool operator()(f32x4 (&acc)[2][2][4][2], const Unit& u, int wr, int wc, int fr, int fq) const {
        const int col0 = u.pn * 256 + wc * 32 + 4 * fq;
#pragma unroll
        for (int ai = 0; ai < 2; ++ai)
#pragma unroll
            for (int m = 0; m < 4; ++m) { const unsigned off = (unsigned)(u.pm * 256 + ai * HALF + wr * 64 + m * 16 + fr) * 1024u + col0;
#pragma unroll
                for (int bj = 0; bj < 2; ++bj)
#pragma unroll
                    for (int n = 0; n < 2; ++n) { const f32x4 xs = *(const f32x4*)(X + off + bj * HALF + n * 16); const f32x4 bv = *(const f32x4*)(bias + col0 + bj * HALF + n * 16);
                        *(f32x4*)(T + off + bj * HALF + n * 16) = acc[ai][bj][m][n] + bv + xs * ALPHA; }
                asm volatile("" ::: "memory"); }
        return false;
    }
};
struct EpiUp {
    static constexpr bool PERM = true, AFTER_DRAIN = false, KEEP = false;
    const float* ROWW; bf16* H;
    __device__ __forceinline__ bool operator()(f32x4 (&acc)[2][2][4][2], const Unit& u, int wr, int wc, int fr, int fq) const {
        const int c0 = u.pn * 128 + wc * 32 + 8 * fq;
#pragma unroll
        for (int ai = 0; ai < 2; ++ai)
#pragma unroll
            for (int m = 0; m < 4; ++m) { const unsigned row = (unsigned)(u.pm * 256 + ai * HALF + wr * 64 + m * 16 + fr); const float w = ROWW[row];
                float h[8];
#pragma unroll
                for (int n = 0; n < 2; ++n)
#pragma unroll
                    for (int e = 0; e < 4; ++e) { const float gv = acc[ai][0][m][n][e], uv = acc[ai][1][m][n][e]; h[n * 4 + e] = gv * pg8::fast_sigmoid(gv) * uv * w; }
                u32x4 o; o.x = pg8::cvt_pk_bf16(h[0], h[1]); o.y = pg8::cvt_pk_bf16(h[2], h[3]); o.z = pg8::cvt_pk_bf16(h[4], h[5]); o.w = pg8::cvt_pk_bf16(h[6], h[7]);
                *(u32x4*)(H + row * DEXP + c0) = o; }
        return false;
    }
};

__device__ __forceinline__ void unpack8(const v4u w, float* f) { f[0] = bf_lo(w.x); f[1] = bf_hi(w.x); f[2] = bf_lo(w.y); f[3] = bf_hi(w.y); f[4] = bf_lo(w.z); f[5] = bf_hi(w.z); f[6] = bf_lo(w.w); f[7] = bf_hi(w.w); }

__device__ __forceinline__ void ph_prologue(const Frame& F, const Args& a) {
    convert_layer_main(F, a, 0);
    { LAS float* scr = (LAS float*)(F.lds + F.wave * 16384); int base = 0;
      for (int l = 0; l < DEPTH; ++l) tr_job(F, scr, a.in[I_W_KV] + (size_t)l * D * 2048, D, 2048, (bf16*)(F.ws + WS_WKVT) + (size_t)l * 2048 * D, D, 0, base); }
    const int gw = F.bid * NWAVES + F.wave, NGW = F.G * NWAVES;
    for (int m = gw; m < M + NB * NMEM; m += NGW) {
        const bool is_x = m < M; const int r = is_x ? m : m - M;
        const float* src = (is_x ? a.in[I_X] : a.in[I_MEM]) + (size_t)r * D;
        f32x4 v[4];
#pragma unroll
        for (int j = 0; j < 4; ++j) v[j] = ((const f32x4*)src)[64 * j + F.lane];
        if (is_x) ln_row_store(v, F.lane, a.in[I_LN_IN_G], a.in[I_LN_IN_B], a.out + (size_t)r * D, (bf16*)(F.ws + WS_XB) + (size_t)r * D);
        else ln_row_store(v, F.lane, a.in[I_LN_MEM_G], a.in[I_LN_MEM_B], nullptr, (bf16*)(F.ws + WS_MEMN) + (size_t)r * D);
    }
}

__device__ __forceinline__ void item_spatial(const Frame& F0, const Args& a, int l, int item) {
    Frame F = F0; { int t_ = threadIdx.x; asm volatile("" : "+v"(t_)); F.tid = t_; F.lane = t_ & 63; }
    const int g = item & 7, bc = item >> 3; const size_t row0 = (size_t)bc * 128;
    const bf16* V = (const bf16*)(F.ws + WS_V); bf16* U = (bf16*)(F.ws + WS_O) + OC_U;
    LAS float* stat = (LAS float*)F.lds;
    LAS float* vn = (LAS float*)(F.lds + 1024);
    for (int i = 0; i < 16; ++i) { const int t = F.wave * 16 + i; const bf16* vr = V + (row0 + t) * 1024;
        float x[16]; unpack8(*(const v4u*)(vr + F.lane * 8), x); unpack8(*(const v4u*)(vr + 512 + F.lane * 8), x + 8);
        float s = 0.f;
#pragma unroll
        for (int e = 0; e < 16; ++e) s += x[e];
        const float mean = wave_sum(s) * (1.f / 1024.f); float q = 0.f;
#pragma unroll
        for (int e = 0; e < 16; ++e) { const float d = x[e] - mean; q += d * d; }
        const float rstd = 1.f / sqrtf(wave_sum(q) * (1.f / 1024.f) + LN_EPS);
        if (F.lane == 0) { stat[2 * t] = mean; stat[2 * t + 1] = rstd; } }
    __syncthreads();
    { const int d = F.tid & 127; const float gg = a.in[I_LN_V_G][l * AW + g * 128 + d], bb = a.in[I_LN_V_B][l * AW + g * 128 + d];
      for (int i = 0; i < 32; ++i) { const int s = (F.tid >> 7) + 4 * i; const float v = bf2f(V[(row0 + s) * 1024 + g * 128 + d]); vn[s * 128 + d] = (v - stat[2 * s]) * stat[2 * s + 1] * gg + bb; } }
    __syncthreads();
    { const int d = F.tid & 127, tq = F.tid >> 7; const float* ws_ = a.in[I_W_S] + (size_t)(l * 8 + g) * 128 * 128; const float* bs_ = a.in[I_B_S] + (l * 8 + g) * 128;
      for (int t = tq * 32; t < tq * 32 + 32; ++t) { const float* wrow = ws_ + t * 128; float acc = 0.f;
          for (int s = 0; s <= t; ++s) acc += wrow[s] * vn[s * 128 + d];
          const size_t idx = (row0 + t) * LDO + g * 128 + d; U[idx] = DBG_ZA ? (bf16)0 : (bf16)f2bf(bf2f(U[idx]) * (acc + bs_[t])); } }
    __syncthreads();
}

__device__ __forceinline__ void item_attn(const Frame& F0, int l, int item) {
    Frame F = F0; { int t_ = threadIdx.x; asm volatile("" : "+v"(t_)); F.tid = t_; F.lane = t_ & 63; }
    const int tile = item & 63, bh = item >> 6, h = bh & 3, b = bh >> 2, lane = F.lane;
    LAS float* qs = (LAS float*)F.lds + F.wave * 2048;
    LAS float* ps = qs + 1024;
    const bf16* Kb = (const bf16*)(F.ws + WS_KV) + ((size_t)(l * 4 + b) * 4 + h) * 65536; const bf16* Vb = (const bf16*)(F.ws + WS_VT) + ((size_t)(l * 4 + b) * 4 + h) * 65536;
    bf16* Q = (bf16*)(F.ws + WS_O) + OC_Q;
    for (int tg = 0; tg < 2; ++tg) {
        const size_t row = (size_t)b * SEQ + tile * 64 + F.wave * 8 + tg * 4;
        { const int tk = lane >> 4, d0 = (lane & 15) * 16; const bf16* qp = Q + (row + tk) * LDO + h * 256 + d0; float x[16]; unpack8(*(const v4u*)qp, x); unpack8(*(const v4u*)(qp + 8), x + 8);
#pragma unroll
          for (int e = 0; e < 16; ++e) qs[tk * 256 + d0 + e] = x[e]; }
        LDS_WAIT(); asm volatile("" ::: "memory");
        float s[4][4];
#pragma unroll
        for (int tk = 0; tk < 4; ++tk)
#pragma unroll
            for (int j = 0; j < 4; ++j) s[tk][j] = 0.f;
        for (int d0 = 0; d0 < 256; d0 += 8) {
            float kv[4][8];
#pragma unroll
            for (int j = 0; j < 4; ++j) unpack8(*(const v4u*)(Kb + (size_t)(lane + 64 * j) * 256 + d0), kv[j]);
#pragma unroll
            for (int tk = 0; tk < 4; ++tk) { const f32x4 q0 = *(const LAS f32x4*)(qs + tk * 256 + d0), q1 = *(const LAS f32x4*)(qs + tk * 256 + d0 + 4);
#pragma unroll
                for (int j = 0; j < 4; ++j) s[tk][j] += (q0[0] * kv[j][0] + q0[1] * kv[j][1]) + (q0[2] * kv[j][2] + q0[3] * kv[j][3]) + (q1[0] * kv[j][4] + q1[1] * kv[j][5]) + (q1[2] * kv[j][6] + q1[3] * kv[j][7]); }
        }
#pragma unroll
        for (int tk = 0; tk < 4; ++tk) { float mx = fmaxf(fmaxf(s[tk][0], s[tk][1]), fmaxf(s[tk][2], s[tk][3])); mx = wave_max(mx);
            float e[4], sum = 0.f;
#pragma unroll
            for (int j = 0; j < 4; ++j) { e[j] = __expf(s[tk][j] - mx); sum += e[j]; }
            sum = wave_sum(sum); const float inv = 1.f / sum;
#pragma unroll
            for (int j = 0; j < 4; ++j) ps[tk * 256 + lane + 64 * j] = e[j] * inv; }
        LDS_WAIT(); asm volatile("" ::: "memory");
        float o[4][4];
#pragma unroll
        for (int tk = 0; tk < 4; ++tk)
#pragma unroll
            for (int e = 0; e < 4; ++e) o[tk][e] = 0.f;
        for (int k = 0; k < 256; k += 4) {
            float v[4][4];
#pragma unroll
            for (int e = 0; e < 4; ++e) { const v2u w = *(const v2u*)(Vb + (size_t)(4 * lane + e) * 256 + k); v[0][e] = bf_lo(w.x); v[1][e] = bf_hi(w.x); v[2][e] = bf_lo(w.y); v[3][e] = bf_hi(w.y); }
#pragma unroll
            for (int tk = 0; tk < 4; ++tk) { const f32x4 p4 = *(const LAS f32x4*)(ps + tk * 256 + k);
#pragma unroll
                for (int kk = 0; kk < 4; ++kk)
#pragma unroll
                    for (int e = 0; e < 4; ++e) o[tk][e] += p4[kk] * v[kk][e]; }
        }
#pragma unroll
        for (int tk = 0; tk < 4; ++tk) *(v2u*)(Q + (row + tk) * LDO + h * 256 + 4 * lane) = DBG_ZC ? (v2u){0u, 0u} : (v2u){pk2(o[tk][0], o[tk][1]), pk2(o[tk][2], o[tk][3])};
        LDS_WAIT(); asm volatile("" ::: "memory");
    }
}

__device__ __forceinline__ void item_lru(const Frame& F0, const Args& a, int l, int item, int pass) {
    Frame F = F0; { int t_ = threadIdx.x; asm volatile("" : "+v"(t_)); F.tid = t_; F.lane = t_ & 63; }
    const int h = item % 10, b = (item / 10) & 3, c = item / 40, ch = h * 128 + (F.tid & 127), j = F.tid & 127, tq = F.tid >> 7;
    LAS float* cx = (LAS float*)F.lds; LAS float* As = cx + 8192; LAS float* Bs = As + 8192;
    const float* wa = a.in[I_W_A] + (size_t)(l * 10 + h) * 128 * 128; const float* wx = a.in[I_W_X] + (size_t)(l * 10 + h) * 128 * 128;
    const float ba = a.in[I_B_A][l * BW + ch], bxb = a.in[I_B_X][l * BW + ch], sp = log1pf(expf(-a.in[I_LAM][l * BW + ch]));
    const float cw0 = a.in[I_CONV_W][(l * 4 + 0) * BW + ch], cw1 = a.in[I_CONV_W][(l * 4 + 1) * BW + ch], cw2 = a.in[I_CONV_W][(l * 4 + 2) * BW + ch], cw3 = a.in[I_CONV_W][(l * 4 + 3) * BW + ch], cb = a.in[I_CONV_B][l * BW + ch];
    const bf16* XBR = (const bf16*)(F.ws + WS_XBR) + (size_t)b * SEQ * BW + ch; bf16* GB = (bf16*)(F.ws + WS_O) + OC_GB + (size_t)b * SEQ * LDO + ch;
    float* SUMM = (float*)(F.ws + WS_SUMM);
    float hst = 0.f, P = 1.f;
    if (pass == 2 && tq == 0) for (int cc = 0; cc < c; ++cc) { const float a_ = SUMM[((size_t)(b * 32 + cc) * BW + ch) * 2], h_ = SUMM[((size_t)(b * 32 + cc) * BW + ch) * 2 + 1]; hst = a_ * hst + h_; }
    for (int half = 0; half < 2; ++half) {
        const int tbase = c * 128 + half * 64;
        for (int tt = 0; tt < 16; ++tt) { const int t = tq * 16 + tt, pos = tbase + t; float acc = cb;
            if (pos >= 3) acc += cw0 * bf2f(XBR[(size_t)(pos - 3) * BW]);
            if (pos >= 2) acc += cw1 * bf2f(XBR[(size_t)(pos - 2) * BW]);
            if (pos >= 1) acc += cw2 * bf2f(XBR[(size_t)(pos - 1) * BW]);
            acc += cw3 * bf2f(XBR[(size_t)pos * BW]);
            cx[t * 128 + j] = acc; }
        __syncthreads();
        float ra[16], rx[16];
#pragma unroll
        for (int tt = 0; tt < 16; ++tt) { ra[tt] = 0.f; rx[tt] = 0.f; }
        for (int i = 0; i < 128; ++i) { const float wai = wa[i * 128 + j], wxi = wx[i * 128 + j];
#pragma unroll
            for (int tt = 0; tt < 16; ++tt) { const float cv = cx[(tq * 16 + tt) * 128 + i]; ra[tt] += cv * wai; rx[tt] += cv * wxi; } }
#pragma unroll
        for (int tt = 0; tt < 16; ++tt) { const int t = tq * 16 + tt; const float r = 1.f / (1.f + expf(-(ra[tt] + ba))), ii = 1.f / (1.f + expf(-(rx[tt] + bxb)));
            const float la = -8.0f * r * sp, av = expf(la), mult = sqrtf(-expm1f(2.f * la)); As[t * 128 + j] = av; Bs[t * 128 + j] = mult * ii * cx[t * 128 + j]; }
        __syncthreads();
        if (tq == 0) for (int t = 0; t < 64; ++t) { const float av = As[t * 128 + j]; hst = av * hst + Bs[t * 128 + j]; P *= av;
            if (pass == 2) { const size_t idx = (size_t)(tbase + t) * LDO; GB[idx] = DBG_ZB ? (bf16)0 : (bf16)f2bf(hst * bf2f(GB[idx])); } }
        __syncthreads();
    }
    if (pass == 1 && tq == 0) { SUMM[((size_t)(b * 32 + c) * BW + ch) * 2] = P; SUMM[((size_t)(b * 32 + c) * BW + ch) * 2 + 1] = hst; }
}


typedef short bf16x8 __attribute__((ext_vector_type(8)));
typedef short s16x4 __attribute__((ext_vector_type(4)));
typedef float f32x16 __attribute__((ext_vector_type(16)));
__device__ __forceinline__ int crow(int r, int hi) { return (r & 3) + 8 * (r >> 2) + 4 * hi; }
#define MFMA32(a, b, c) __builtin_amdgcn_mfma_f32_32x32x16_bf16((a), (b), (c), 0, 0, 0)
__device__ __forceinline__ s16x4 lds_tr4(const LAS unsigned char* p) { typedef short v4i16_t __attribute__((ext_vector_type(4))); return __builtin_bit_cast(s16x4, __builtin_amdgcn_ds_read_tr16_b64_v4i16((LAS v4i16_t*)p)); }
__device__ __forceinline__ float neg_expm1(float x) { return -x * (1.f + x * (0.5f + x * (0.16666667f + x * (0.041666668f + x * 0.0083333338f)))); }

__device__ __forceinline__ void item_spatial_mfma(const Frame& F0, const Args& a, int l, int item) {
    Frame F = F0; { int t_ = threadIdx.x; asm volatile("" : "+v"(t_)); F.tid = t_; F.lane = t_ & 63; }
    const int g = item & 7, bc = item >> 3, lane = F.lane, w = F.wave, hi = lane >> 5; const size_t row0 = (size_t)bc * 128;
    const GAS bf16* V = (const GAS bf16*)(F.ws + WS_V); GAS bf16* U = (GAS bf16*)(F.ws + WS_O) + OC_U;
    LAS float* stat = (LAS float*)F.lds;
    LAS unsigned char* vn = F.lds + 1024;
    LAS float* so = (LAS float*)(F.lds + 36864);
    for (int i = 0; i < 16; ++i) { const int t = w * 16 + i; const GAS bf16* vr = V + (row0 + t) * 1024;
        float x[16]; unpack8(*(const GAS v4u*)(vr + lane * 8), x); unpack8(*(const GAS v4u*)(vr + 512 + lane * 8), x + 8);
        float s1 = 0.f;
#pragma unroll
        for (int e = 0; e < 16; ++e) s1 += x[e];
        const float mean = wave_sum(s1) * (1.f / 1024.f); float q = 0.f;
#pragma unroll
        for (int e = 0; e < 16; ++e) { const float d = x[e] - mean; q += d * d; }
        const float rstd = 1.f / sqrtf(wave_sum(q) * (1.f / 1024.f) + LN_EPS);
        if (lane == 0) { stat[2 * t] = mean; stat[2 * t + 1] = rstd; } }
    __syncthreads();
    { const int dc = F.tid & 15; float gg[8], bb[8];
#pragma unroll
      for (int e = 0; e < 8; ++e) { gg[e] = a.in[I_LN_V_G][l * AW + g * 128 + dc * 8 + e]; bb[e] = a.in[I_LN_V_B][l * AW + g * 128 + dc * 8 + e]; }
#pragma unroll
      for (int i = 0; i < 4; ++i) { const int sx = (F.tid >> 4) + 32 * i; float x[8]; unpack8(*(const GAS v4u*)(V + (row0 + sx) * 1024 + g * 128 + dc * 8), x);
          const float mean = stat[2 * sx], rstd = stat[2 * sx + 1];
#pragma unroll
          for (int e = 0; e < 8; ++e) x[e] = (x[e] - mean) * rstd * gg[e] + bb[e];
          *(LAS v4u*)(vn + sx * 272 + dc * 16) = (v4u){pk2(x[0], x[1]), pk2(x[2], x[3]), pk2(x[4], x[5]), pk2(x[6], x[7])}; } }
    __syncthreads();
    { const int tt = w >> 1, dt0 = 2 * (w & 1); f32x16 acc[2]; acc[0] = f32x16{}; acc[1] = f32x16{};
      const GAS bf16* wrow = (const GAS bf16*)(F.ws + WS_WSB) + (size_t)(g * 128 + 32 * tt + (lane & 31)) * 128 + 8 * hi;
      const int q = (lane & 15) >> 2, p = lane & 3, blk = (lane >> 4) & 1;
      const LAS unsigned char* vb = vn + 272 * (8 * hi + q) + 2 * (16 * blk + 4 * p);
      for (int ks = 0; ks < 2 * tt + 2; ++ks) {
          const bf16x8 A = *(const GAS bf16x8*)(wrow + 16 * ks);
#pragma unroll
          for (int u = 0; u < 2; ++u) { const s16x4 lo = lds_tr4(vb + 272 * 16 * ks + 64 * (dt0 + u)), h4 = lds_tr4(vb + 272 * (16 * ks + 4) + 64 * (dt0 + u));
              const bf16x8 B = {lo[0], lo[1], lo[2], lo[3], h4[0], h4[1], h4[2], h4[3]};
              acc[u] = MFMA32(A, B, acc[u]); } }
#pragma unroll
      for (int u = 0; u < 2; ++u)
#pragma unroll
          for (int r = 0; r < 16; ++r) so[(32 * tt + crow(r, hi)) * 128 + 32 * (dt0 + u) + (lane & 31)] = acc[u][r]; }
    __syncthreads();
    { const int dc = F.tid & 15; const float* bs_ = a.in[I_B_S] + (l * 8 + g) * 128;
#pragma unroll
      for (int i = 0; i < 4; ++i) { const int t = (F.tid >> 4) + 32 * i; const float bt = bs_[t]; GAS bf16* up = U + (row0 + t) * LDO + g * 128 + dc * 8;
          float x[8]; unpack8(*(const GAS v4u*)up, x); const f32x4 s0 = *(const LAS f32x4*)(so + t * 128 + dc * 8), s1 = *(const LAS f32x4*)(so + t * 128 + dc * 8 + 4);
          *(GAS v4u*)up = (v4u){pk2(x[0] * (s0[0] + bt), x[1] * (s0[1] + bt)), pk2(x[2] * (s0[2] + bt), x[3] * (s0[3] + bt)), pk2(x[4] * (s1[0] + bt), x[5] * (s1[1] + bt)), pk2(x[6] * (s1[2] + bt), x[7] * (s1[3] + bt))}; } }
    __syncthreads();
}

__device__ __forceinline__ void item_attn_mfma(const Frame& F0, int l, int item) {
    Frame F = F0; { int t_ = threadIdx.x; asm volatile("" : "+v"(t_)); F.tid = t_; F.lane = t_ & 63; }
    const int tile = item & 15, bh = item >> 4, hd = bh & 3, b = bh >> 2, lane = F.lane, hi = lane >> 5, r32 = lane & 31;
    const GAS bf16* Kb = (const GAS bf16*)(F.ws + WS_KV) + ((size_t)(l * 4 + b) * 4 + hd) * 65536 + (size_t)r32 * 256 + 8 * hi;
    const GAS bf16* Vt = (const GAS bf16*)(F.ws + WS_VT) + ((size_t)(l * 4 + b) * 4 + hd) * 65536 + (size_t)r32 * 256 + 4 * hi;
    GAS bf16* Qp = (GAS bf16*)(F.ws + WS_O) + OC_Q + ((size_t)b * SEQ + tile * 256 + F.wave * 32 + r32) * LDO + hd * 256;
    bf16x8 qf[16];
#pragma unroll
    for (int ks = 0; ks < 16; ++ks) qf[ks] = *(const GAS bf16x8*)(Qp + 16 * ks + 8 * hi);
    float mx = -3.0e38f;
#pragma unroll 1
    for (int kt = 0; kt < 8; ++kt) { f32x16 sacc = f32x16{};
#pragma unroll
        for (int ks = 0; ks < 16; ++ks) sacc = MFMA32(*(const GAS bf16x8*)(Kb + kt * 8192 + 16 * ks), qf[ks], sacc);
#pragma unroll
        for (int r = 0; r < 16; ++r) mx = fmaxf(mx, sacc[r]); }
    mx = fmaxf(mx, __shfl_xor(mx, 32));
    unsigned pp[8][8]; float lsum = 0.f;
#pragma unroll
    for (int kt = 0; kt < 8; ++kt) { f32x16 sacc = f32x16{};
#pragma unroll
        for (int ks = 0; ks < 16; ++ks) { sacc = MFMA32(*(const GAS bf16x8*)(Kb + kt * 8192 + 16 * ks), qf[ks], sacc); if ((ks & 7) == 7) asm volatile("" ::: "memory"); }
#pragma unroll
        for (int r = 0; r < 16; r += 2) { const float p0 = __builtin_amdgcn_exp2f(sacc[r] - mx), p1 = __builtin_amdgcn_exp2f(sacc[r + 1] - mx); lsum += p0 + p1; pp[kt][r >> 1] = pg8::cvt_pk_bf16(p0, p1); } }
    lsum += __shfl_xor(lsum, 32);
    const float inv = 1.0f / lsum;
#pragma unroll 1
    for (int dt = 0; dt < 8; ++dt) { f32x16 o = f32x16{};
#pragma unroll
        for (int kt = 0; kt < 8; ++kt)
#pragma unroll
            for (int sx = 0; sx < 2; ++sx) { const GAS bf16* vp = Vt + dt * 8192 + 32 * kt + 16 * sx; const v2u lo = *(const GAS v2u*)vp, h2 = *(const GAS v2u*)(vp + 8);
                const v4u av = {lo.x, lo.y, h2.x, h2.y}; const v4u bv = {pp[kt][4 * sx], pp[kt][4 * sx + 1], pp[kt][4 * sx + 2], pp[kt][4 * sx + 3]};
                o = MFMA32(__builtin_bit_cast(bf16x8, av), __builtin_bit_cast(bf16x8, bv), o); }
#pragma unroll
        for (int gq = 0; gq < 4; ++gq) *(GAS v2u*)(Qp + 32 * dt + 8 * gq + 4 * hi) = (v2u){pk2(o[4 * gq] * inv, o[4 * gq + 1] * inv), pk2(o[4 * gq + 2] * inv, o[4 * gq + 3] * inv)}; }
}

__device__ __forceinline__ void item_lru_mfma(const Frame& F0, const Args& a, int l, int item, int pass) {
    Frame F = F0; { int t_ = threadIdx.x; asm volatile("" : "+v"(t_)); F.tid = t_; F.lane = t_ & 63; }
    const int hh = item % 10, b = (item / 10) & 3, c = item / 40, j = F.tid & 127, tq = F.tid >> 7, ch = hh * 128 + j, lane = F.lane, w = F.wave, hi = lane >> 5, r32 = lane & 31;
    LAS unsigned char* cxb = F.lds;
    LAS float* As = (LAS float*)(F.lds + 36864);
    LAS float* Bs = As + 8192;
    LAS float* seg = Bs + 8192;
    LAS float* car = seg + 1024;
    const GAS bf16* XBR = (const GAS bf16*)(F.ws + WS_XBR) + (size_t)b * SEQ * BW + ch; GAS bf16* GBp = (GAS bf16*)(F.ws + WS_O) + OC_GB + (size_t)b * SEQ * LDO + ch;
    float* SUMM = (float*)(F.ws + WS_SUMM);
    { const float cw0 = a.in[I_CONV_W][(l * 4 + 0) * BW + ch], cw1 = a.in[I_CONV_W][(l * 4 + 1) * BW + ch], cw2 = a.in[I_CONV_W][(l * 4 + 2) * BW + ch], cw3 = a.in[I_CONV_W][(l * 4 + 3) * BW + ch], cb = a.in[I_CONV_B][l * BW + ch];
      const int p0 = c * 128 + tq * 32;
      float x0 = (p0 >= 3) ? bf2f(XBR[(size_t)(p0 - 3) * BW]) : 0.f, x1 = (p0 >= 2) ? bf2f(XBR[(size_t)(p0 - 2) * BW]) : 0.f, x2 = (p0 >= 1) ? bf2f(XBR[(size_t)(p0 - 1) * BW]) : 0.f;
#pragma unroll 4
      for (int tt = 0; tt < 32; ++tt) { const float x3 = bf2f(XBR[(size_t)(p0 + tt) * BW]); const float cv = cb + cw0 * x0 + cw1 * x1 + cw2 * x2 + cw3 * x3;
          *(LAS bf16*)(cxb + (tq * 32 + tt) * 272 + j * 2) = (bf16)f2bf(cv); x0 = x1; x1 = x2; x2 = x3; }
      if (tq == 0) { float hst = 0.f;
          if (pass == 2) for (int cc = 0; cc < c; ++cc) { const float a_ = SUMM[((size_t)(b * 32 + cc) * BW + ch) * 2], h_ = SUMM[((size_t)(b * 32 + cc) * BW + ch) * 2 + 1]; hst = a_ * hst + h_; }
          car[j] = hst; car[128 + j] = 1.f; } }
    __syncthreads();
    const int tt = w >> 1, jt0 = 2 * (w & 1);
    f32x16 ra[2], rx[2]; ra[0] = f32x16{}; ra[1] = f32x16{}; rx[0] = f32x16{}; rx[1] = f32x16{};
    { const GAS bf16* wa = (const GAS bf16*)(F.ws + WS_WAT) + (size_t)hh * 16384 + (size_t)(32 * jt0 + r32) * 128 + 8 * hi; const GAS bf16* wx = (const GAS bf16*)(F.ws + WS_WXT) + (size_t)hh * 16384 + (size_t)(32 * jt0 + r32) * 128 + 8 * hi;
#pragma unroll
      for (int ks = 0; ks < 8; ++ks) { const bf16x8 A = *(const LAS bf16x8*)(cxb + (32 * tt + r32) * 272 + (16 * ks + 8 * hi) * 2);
#pragma unroll
          for (int u = 0; u < 2; ++u) { ra[u] = MFMA32(A, *(const GAS bf16x8*)(wa + u * 4096 + 16 * ks), ra[u]); rx[u] = MFMA32(A, *(const GAS bf16x8*)(wx + u * 4096 + 16 * ks), rx[u]); } } }
#pragma unroll
    for (int u = 0; u < 2; ++u) { const int cj = hh * 128 + 32 * (jt0 + u) + r32; const float ba = a.in[I_B_A][l * BW + cj], bx = a.in[I_B_X][l * BW + cj], sp = log1pf(__expf(-a.in[I_LAM][l * BW + cj]));
#pragma unroll
        for (int r = 0; r < 16; ++r) { const int t = 32 * tt + crow(r, hi); const float cv = bf2f(*(const LAS bf16*)(cxb + t * 272 + (32 * (jt0 + u) + r32) * 2));
            const float rr = pg8::fast_sigmoid(ra[u][r] + ba), ii = pg8::fast_sigmoid(rx[u][r] + bx), la = -8.0f * rr * sp;
            ra[u][r] = __builtin_amdgcn_exp2f(la * 1.4426950408889634f); rx[u][r] = sqrtf(neg_expm1(2.f * la)) * ii * cv; } }
    for (int half = 0; half < 2; ++half) {
        if ((tt >> 1) == half) {
#pragma unroll
            for (int u = 0; u < 2; ++u)
#pragma unroll
                for (int r = 0; r < 16; ++r) { const int tl = 32 * (tt & 1) + crow(r, hi), cj = 32 * (jt0 + u) + r32; As[tl * 128 + cj] = ra[u][r]; Bs[tl * 128 + cj] = rx[u][r]; } }
        __syncthreads();
        { float P = 1.f, H = 0.f;
#pragma unroll 4
          for (int k = 0; k < 16; ++k) { const float a_ = As[(tq * 16 + k) * 128 + j]; H = a_ * H + Bs[(tq * 16 + k) * 128 + j]; P *= a_; }
          seg[(tq * 128 + j) * 2] = P; seg[(tq * 128 + j) * 2 + 1] = H; }
        __syncthreads();
        float hc = car[j], pc = car[128 + j];
        for (int s2 = 0; s2 < tq; ++s2) { hc = seg[(s2 * 128 + j) * 2] * hc + seg[(s2 * 128 + j) * 2 + 1]; }
        if (pass == 2) { float h = hc; const size_t t0 = (size_t)(c * 128 + half * 64 + tq * 16);
#pragma unroll 4
            for (int k = 0; k < 16; ++k) { h = As[(tq * 16 + k) * 128 + j] * h + Bs[(tq * 16 + k) * 128 + j]; GAS bf16* gp = GBp + (t0 + k) * LDO; *gp = (bf16)f2bf(h * bf2f(*gp)); } }
        if (tq == 3) { hc = seg[(3 * 128 + j) * 2] * hc + seg[(3 * 128 + j) * 2 + 1];
            pc *= seg[(0 * 128 + j) * 2] * seg[(1 * 128 + j) * 2] * seg[(2 * 128 + j) * 2] * seg[(3 * 128 + j) * 2]; }
        __syncthreads();
        if (tq == 3) { car[j] = hc; car[128 + j] = pc; }
        __syncthreads();
    }
    if (pass == 1 && tq == 0) { SUMM[((size_t)(b * 32 + c) * BW + ch) * 2] = car[128 + j]; SUMM[((size_t)(b * 32 + c) * BW + ch) * 2 + 1] = car[j]; }
    __syncthreads();
}

__device__ __forceinline__ void ph_router(const Frame& F, const Args& a, int l, const bf16*  ) {
    LAS int* s_e = (LAS int*)F.lds; LAS float* s_w = (LAS float*)(F.lds + 512); LAS int* s_cnt = (LAS int*)(F.lds + 1024); LAS int* s_base = s_cnt + 16;
    const float* wrg = a.in[I_W_RG] + (size_t)l * D * 4; const float* wre = a.in[I_W_RE] + (size_t)l * D * 16; const float* brg = a.in[I_B_RG] + l * 4; const float* bre = a.in[I_B_RE] + l * 16;
    int* EID = (int*)(F.ws + WS_META); int* POS = EID + NPAIR; float* WGT = (float*)(POS + NPAIR);
    gu32* gcnt = F.ctl + CW_MOE + l * 16 * 64;
    for (int tb = F.bid; tb < M / 64; tb += F.G) {
        if (F.tid < 16) s_cnt[F.tid] = 0;
        for (int i = 0; i < 8; ++i) { const int tok = tb * 64 + F.wave * 8 + i; const float* xr = a.out + (size_t)tok * D;
            float lg[20];
#pragma unroll
            for (int o = 0; o < 20; ++o) lg[o] = 0.f;
#pragma unroll 2
            for (int i2 = 0; i2 < 16; ++i2) { const int d = 64 * i2 + F.lane; const float x = xr[d];
                const f32x4 g4 = *(const f32x4*)(wrg + d * 4);
#pragma unroll
                for (int o = 0; o < 4; ++o) lg[o] += x * g4[o];
#pragma unroll
                for (int q = 0; q < 4; ++q) { const f32x4 e4 = *(const f32x4*)(wre + d * 16 + 4 * q);
#pragma unroll
                    for (int o = 0; o < 4; ++o) lg[4 + 4 * q + o] += x * e4[o]; } }
#pragma unroll
            for (int o = 0; o < 20; ++o) lg[o] = wave_sum(lg[o]);
            if (F.lane == 0) {
                float gl[4]; int gt = 0;
#pragma unroll
                for (int o = 0; o < 4; ++o) gl[o] = lg[o] + brg[o];
                float gm = gl[0];
#pragma unroll
                for (int o = 1; o < 4; ++o) if (gl[o] > gm) { gm = gl[o]; gt = o; }
                float gs = 0.f;
#pragma unroll
                for (int o = 0; o < 4; ++o) gs += expf(gl[o] - gm);
                const float ptop = 1.f / gs;
                float el[4];
#pragma unroll
                for (int o = 0; o < 4; ++o) { float v = 0.f;
#pragma unroll
                    for (int q = 0; q < 4; ++q) v = (gt == q) ? lg[4 + 4 * q + o] + bre[4 * q + o] : v;
                    el[o] = v; }
                int i1 = 0;
#pragma unroll
                for (int o = 1; o < 4; ++o) if (el[o] > el[i1]) i1 = o;
                int i2 = (i1 == 0) ? 1 : 0;
#pragma unroll
                for (int o = 0; o < 4; ++o) if (o != i1 && o != i2 && el[o] > el[i2]) i2 = o;
                const float e1 = 1.f, e2 = expf(el[i2] - el[i1]); const float inv = ptop / (e1 + e2);
                const int p = (F.wave * 8 + i) * 2;
                s_e[p] = gt * 4 + i1; s_w[p] = e1 * inv; s_e[p + 1] = gt * 4 + i2; s_w[p + 1] = e2 * inv;
            } }
        __syncthreads();
        int mye = 0, mypos = 0;
        if (F.tid < 128) { mye = s_e[F.tid]; for (int q = 0; q < F.tid; ++q) mypos += (s_e[q] == mye) ? 1 : 0; atomicAdd((int*)&s_cnt[mye], 1); }
        __syncthreads();
        if (F.tid < 16) s_base[F.tid] = (int)__hip_atomic_fetch_add(gcnt + 64 * F.tid, (unsigned)s_cnt[F.tid], RLX_AGENT);
        __syncthreads();
        if (F.tid < 128) { const int p = tb * 128 + F.tid; EID[p] = mye; POS[p] = s_base[mye] + mypos; WGT[p] = s_w[F.tid]; }
        __syncthreads();
    }
}
__device__ __forceinline__ void ph_gather(const Frame& F, int l) {
    const int* EID = (const int*)(F.ws + WS_META); const int* POS = EID + NPAIR; const float* WGT = (const float*)(POS + NPAIR); int* ROWOF = (int*)(WGT + NPAIR); float* ROWW = (float*)(ROWOF + NPAIR);
    gu32* gcnt = F.ctl + CW_MOE + l * 16 * 64;
    const bf16* X1B = (const bf16*)(F.ws + WS_X1B); bf16* XG = (bf16*)(F.ws + WS_XG);
    const int gw = F.bid * NWAVES + F.wave, NGW = F.G * NWAVES;
    for (int p = gw; p < NPAIR; p += NGW) {
        const int e = EID[p]; int off = 0;
        for (int k = 0; k < NEXP; ++k) { const int n = (int)((__hip_atomic_load(gcnt + 64 * k, RLX_AGENT) + 255u) & ~255u); off += (k < e) ? n : 0; }
        const int row = off + POS[p];
        const v4u* src = (const v4u*)(X1B + (size_t)(p >> 1) * D); v4u* dst = (v4u*)(XG + (size_t)row * D);
        dst[F.lane] = src[F.lane]; dst[64 + F.lane] = src[64 + F.lane];
        if (F.lane == 0) { ROWOF[p] = row; ROWW[row] = WGT[p]; }
    }
}
__device__ __forceinline__ void ph_combine(const Frame& F, const Args& a, int l) {
    const int* ROWOF = (const int*)(F.ws + WS_META) + 3 * NPAIR; const bf16* F2 = (const bf16*)(F.ws + WS_F2);
    const int gw = F.bid * NWAVES + F.wave, NGW = F.G * NWAVES;
    for (int m = gw; m < M; m += NGW) {
        const int r0 = ROWOF[2 * m], r1 = ROWOF[2 * m + 1];
        f32x4 v[4];
#pragma unroll
        for (int j = 0; j < 4; ++j) { const f32x4 x = ((const f32x4*)(a.out + (size_t)m * D))[64 * j + F.lane];
            const v2u w0 = ((const v2u*)(F2 + (size_t)r0 * D))[64 * j + F.lane], w1 = ((const v2u*)(F2 + (size_t)r1 * D))[64 * j + F.lane];
            v[j] = x * ALPHA + ((f32x4){bf_lo(w0.x), bf_hi(w0.x), bf_lo(w0.y), bf_hi(w0.y)} + (f32x4){bf_lo(w1.x), bf_hi(w1.x), bf_lo(w1.y), bf_hi(w1.y)}) * DBG_FSCALE; }
        ln_row_store(v, F.lane, a.in[I_LN2_G] + l * D, a.in[I_LN2_B] + l * D, a.out + (size_t)m * D, (bf16*)(F.ws + WS_XB) + (size_t)m * D);
    }
}

__device__ __forceinline__ void ph_ln1(const Frame& F, const Args& a, int l) {
    const float* T = (const float*)(F.ws + WS_F2);
    const int gw = F.bid * NWAVES + F.wave, NGW = F.G * NWAVES;
    for (int m = gw; m < M; m += NGW) {
        f32x4 v[4];
#pragma unroll
        for (int j = 0; j < 4; ++j) v[j] = ((const f32x4*)(T + (size_t)m * D))[64 * j + F.lane];
        ln_row_store(v, F.lane, a.in[I_LN1_G] + l * D, a.in[I_LN1_B] + l * D, a.out + (size_t)m * D, (bf16*)(F.ws + WS_X1B) + (size_t)m * D);
    }
}

constexpr int PH_PER_LAYER = 12, N_PHASES = 1 + DEPTH * PH_PER_LAYER;
__global__ void __launch_bounds__(NWAVES * 64, 2) mk_fwd(Args args) {
    extern __shared__ __attribute__((aligned(16))) unsigned char lds[];
    Frame F;
    F.lds = (LAS unsigned char*)lds; F.ws = args.ws; F.ctl = (gu32*)(args.ws + WS_CTL);
    F.tid = threadIdx.x; F.lane = F.tid & 63; F.wave = __builtin_amdgcn_readfirstlane(F.tid >> 6); F.G = gridDim.x; F.bid = blockIdx.x;
    volatile LAS unsigned* MISC = (volatile LAS unsigned*)(F.lds + MISC_OFF);
    for (int u = F.tid; u < (LDS_BYTES - LDSCTL_OFF) / 4; u += NWAVES * 64) ((LAS unsigned*)(F.lds + LDSCTL_OFF))[u] = 0u;
    __syncthreads();
    XcdBarrier bar; bar.bar = (unsigned*)(F.ctl + CW_BAR); bar.x = 0; bar.st = nullptr;
    if (!MK_PER_PHASE) bar = xcd_barrier_post((unsigned*)(F.ctl + CW_BAR), MISC + 8);
    const int lo = args.ph_lo, hi = args.ph_hi;
    unsigned char* ws = args.ws;
#ifndef PMASK
#define PMASK 0x1fff
#endif
#define IN(k) (lo <= (k) && (k) < hi)
#define EN(j) ((PMASK >> (j)) & 1)
#define LAUNDER() do { int t_ = threadIdx.x; asm volatile("" : "+v"(t_)); F.tid = t_; F.lane = t_ & 63; F.wave = __builtin_amdgcn_readfirstlane(t_ >> 6); \
        unsigned char* w_ = args.ws; asm volatile("" : "+s"(w_)); ws = w_; F.ws = w_; F.ctl = (gu32*)(w_ + WS_CTL); } while (0)
#ifdef NOKV
#define defined_NOKV 1
#else
#define defined_NOKV 0
#endif
#define SEAM(k) do { if (IN((k) + 1)) xcd_barrier(bar); } while (0)

    if (EN(0) && IN(0)) { LAUNDER(); ph_prologue(F, args); SEAM(0); }

#pragma unroll 1
    for (int l = 0; l < DEPTH; ++l) {
        const int p0 = 1 + l * PH_PER_LAYER;
        if (EN(1) && IN(p0 + 0)) { LAUNDER();
            if (!defined_NOKV && l == 0) { SchedKV S{(const char*)(ws + WS_MEMN), (const char*)(ws + WS_WKVT), F.G, F.bid}; EpiKV E{(bf16*)(ws + WS_KV)};
                pg8::gemm_phase<EpiKV, SchedKV, true>(F.lds, S, E); }
            SchedDense S; S.init(ws + WS_XB, ws + WS_WINT, D, M, NZ1, F.G, F.bid);
            EpiInProj E{(bf16*)(ws + WS_O), (bf16*)(ws + WS_V), (bf16*)(ws + WS_XBR), args.in[I_B_IN] + (size_t)l * INW};
            pg8::gemm_phase<EpiInProj, SchedDense, true>(F.lds, S, E);
            SEAM(p0 + 0);
        }
        if (EN(2) && IN(p0 + 1)) { LAUNDER();
            constexpr int NC = USE_MFMA_C ? 256 : 1024;
            for (int it = F.bid; it < NC + 1280 + 1024; it += F.G) {
                if (it < NC) { if (USE_MFMA_C) item_attn_mfma(F, l, it); else item_attn(F, l, it); }
                else if (it < NC + 1280) { if (USE_MFMA_B) item_lru_mfma(F, args, l, it - NC, 1); else item_lru(F, args, l, it - NC, 1); }
                else { if (USE_MFMA_A) item_spatial_mfma(F, args, l, it - NC - 1280); else item_spatial(F, args, l, it - NC - 1280); }
                __syncthreads();
            }
            SEAM(p0 + 1);
        }
        if (EN(3) && IN(p0 + 2)) { LAUNDER(); for (int it = F.bid; it < 1280; it += F.G) { if (USE_MFMA_B) item_lru_mfma(F, args, l, it, 2); else item_lru(F, args, l, it, 2); __syncthreads(); } SEAM(p0 + 2); }
        if (EN(4) && IN(p0 + 3)) { LAUNDER();
            SchedDense S; S.init(ws + WS_XB, ws + WS_WINT + (size_t)NZ1 * D * 2, D, M, NMG, F.G, F.bid);
            EpiGate E{(bf16*)(ws + WS_GA), args.in[I_B_IN] + (size_t)l * INW + NZ1};
            pg8::gemm_phase<EpiGate, SchedDense, true>(F.lds, S, E);
            SEAM(p0 + 3);
        }
        if (EN(5) && IN(p0 + 4)) { LAUNDER();
            SchedY S; S.init(ws, F.G, F.bid); EpiY E{(const bf16*)(ws + WS_GA), (const bf16*)(ws + WS_GBT), (const bf16*)(ws + WS_GC), (bf16*)(ws + WS_Y)};
            pg8::gemm_phase<EpiY, SchedY, false>(F.lds, S, E);
            SEAM(p0 + 4);
        }
        if (EN(6) && IN(p0 + 5)) { LAUNDER();
            const unsigned poison = (__hip_atomic_load(F.ctl + CW_TMO, RLX_AGENT) != 0u) || (F.G != 256);
            SchedDense S; S.init(ws + WS_Y, ws + WS_WOT, D, M, D, F.G, F.bid);
            pg8::PanelStats st{(unsigned*)(ws + WS_XCHG + (size_t)l * 524288), (unsigned*)(F.ctl + CW_SEAM + l * SEAM_BANK), (unsigned*)(F.ctl + CW_TMO), 4, LN_EPS, 0x700u + 0x40u * l};
            EpiLn E{args.out, (bf16*)(ws + WS_X1B), args.in[I_B_O] + l * D, args.in[I_LN1_G] + l * D, args.in[I_LN1_B] + l * D, st, poison};
            if (USE_FUSED_LN) { if (F.G == 256) pg8::gemm_phase<EpiLn, SchedDense, false>(F.lds, S, E); }
            else { EpiF32Res E2{args.out, (float*)(ws + WS_F2), args.in[I_B_O] + l * D}; pg8::gemm_phase<EpiF32Res, SchedDense, true>(F.lds, S, E2);
                 }
            SEAM(p0 + 5);
        }
        if (EN(7) && IN(p0 + 6)) { LAUNDER(); if (!USE_FUSED_LN) ph_ln1(F, args, l); SEAM(p0 + 6); }
        if (EN(8) && IN(p0 + 7)) { LAUNDER(); ph_router(F, args, l, nullptr); __syncthreads(); convert_layer_moe(F, args, l); SEAM(p0 + 7); }
        if (EN(9) && IN(p0 + 8)) { LAUNDER(); ph_gather(F, l); SEAM(p0 + 8); }
        if (EN(10) && IN(p0 + 9)) { LAUNDER();
            SchedMoE S{(const char*)(ws + WS_XG), D, (const char*)(ws + WS_WUPT), (size_t)512 * D * 2, 2, F.ctl + CW_MOE + l * 16 * 64, F.G, F.bid, D};
            EpiUp E{(const float*)(ws + WS_META) + 4 * NPAIR, (bf16*)(ws + WS_H)};
            pg8::gemm_phase<EpiUp, SchedMoE, true>(F.lds, S, E);
            SEAM(p0 + 9);
        }
        if (EN(11) && IN(p0 + 10)) { LAUNDER();
            SchedMoE S{(const char*)(ws + WS_H), DEXP, (const char*)(ws + WS_WDNT), (size_t)D * DEXP * 2, 4, F.ctl + CW_MOE + l * 16 * 64, F.G, F.bid, DEXP};
            EpiPlain E{(bf16*)(ws + WS_F2), D};
            pg8::gemm_phase<EpiPlain, SchedMoE, true>(F.lds, S, E);
            SEAM(p0 + 10);
        }
        if (EN(12) && IN(p0 + 11)) { LAUNDER(); ph_combine(F, args, l); if (l + 1 < DEPTH) { __syncthreads(); convert_layer_main(F, args, l + 1); } SEAM(p0 + 11); }
    }
#undef IN
#undef SEAM
}


extern "C" void kernel_launch(void* const* d_in, const int* in_sizes, int n_in, void* d_out, int out_size, void* d_ws, size_t ws_size, hipStream_t stream) {
    static int grid = 0;
    if (grid == 0) {
        if (n_in != 35 || in_sizes[0] != M * D || out_size != M * D || ws_size < WS_END) { fprintf(stderr, "kernel_launch: unexpected problem (n_in %d, in0 %d, out %d, ws %zu < %zu); nothing launched\n", n_in, n_in > 0 ? in_sizes[0] : -1, out_size, ws_size, (size_t)WS_END); grid = -1; return; }
        if (hipFuncSetAttribute((const void*)mk_fwd, hipFuncAttributeMaxDynamicSharedMemorySize, LDS_BYTES) != hipSuccess) { fprintf(stderr, "kernel_launch: hipFuncSetAttribute failed\n"); grid = -1; return; }
        int per_cu = 0;
        if (hipOccupancyMaxActiveBlocksPerMultiprocessor(&per_cu, (const void*)mk_fwd, NWAVES * 64, LDS_BYTES) != hipSuccess || per_cu < 1) fprintf(stderr, "kernel_launch: occupancy query reports %d workgroups per CU\n", per_cu);
        (void)hipGetLastError();
        grid = 256;
    }
    if (grid < 0) return;
    if (hipMemsetAsync((char*)d_ws + WS_CTL, 0, CTL_ZERO_BYTES, stream) != hipSuccess) { fprintf(stderr, "kernel_launch: hipMemsetAsync failed\n"); return; }
    Args a{};
    for (int i = 0; i < 35; ++i) a.in[i] = (const float*)d_in[i];
    a.out = (float*)d_out; a.ws = (unsigned char*)d_ws;
#if MK_PER_PHASE
    for (int p = 0; p < N_PHASES; ++p) { a.ph_lo = p; a.ph_hi = p + 1; hipLaunchKernelGGL(mk_fwd, dim3(grid), dim3(NWAVES * 64), LDS_BYTES, stream, a);
    }
#else
    a.ph_lo = 0; a.ph_hi = N_PHASES; hipLaunchKernelGGL(mk_fwd, dim3(grid), dim3(NWAVES * 64), LDS_BYTES, stream, a);
#endif
    const hipError_t le = hipPeekAtLastError();
    if (le != hipSuccess) fprintf(stderr, "kernel_launch: launch failed: %s\n", hipGetErrorName(le));
}
```
